# Optimizing an MI355X kernel written in HIP

```python
import math
import jax
import jax.numpy as jnp
from jax import lax
import numpy as np

D_MODEL = 2048
BATCH = 8
SEQ = 2048
DEPTH = 4
DEC_BATCH = 8
DEC_SEQ = 16
PAST_LEN = 4096

CHUNK = 64
DK = 128
DV = 128
NK = D_MODEL // DK
NV = 2 * NK
KEY_DIM = NK * DK
VAL_DIM = NV * DV
QKV_DIM = 2 * KEY_DIM + VAL_DIM
IN_DIM = QKV_DIM + VAL_DIM + 2 * NV
CONV_W = 4
POOL_WINDOWS = (2, 4, 8, 16)
N_GROUPS = 4
GC = D_MODEL // N_GROUPS
POOL_BUF = max(POOL_WINDOWS) - 1
FFN_HIDDEN = -(-8 * D_MODEL // 768) * 256
N_A = (DEPTH + 1) // 2
N_B = DEPTH // 2
EPS = 1e-6

kernel_name = 'hybrid_gdn_pool_stream_step'


def _rms_norm(x, w):
    xf = x.astype(jnp.float32)
    y = xf * lax.rsqrt(jnp.mean(xf * xf, axis=-1, keepdims=True) + EPS)
    return (y * w.astype(jnp.float32)).astype(x.dtype)


def _l2norm(x):
    return x * lax.rsqrt(jnp.sum(x * x, axis=-1, keepdims=True) + EPS)


def _to_chunks(a, n, c):
    b, _, h = a.shape[:3]
    a = a.reshape((b, n, c, h) + a.shape[3:])
    return jnp.moveaxis(a, 3, 1)


def _gated_delta_rule(q, k, v, g, beta, S0):
    B, T, H, _ = q.shape
    C = min(CHUNK, T)
    pad = (-T) % C
    if pad:
        p4 = ((0, 0), (0, pad), (0, 0), (0, 0))
        q, k, v = jnp.pad(q, p4), jnp.pad(k, p4), jnp.pad(v, p4)
        g, beta = jnp.pad(g, p4[:3]), jnp.pad(beta, p4[:3])
    N = (T + pad) // C
    q, k, v = _to_chunks(q, N, C), _to_chunks(k, N, C), _to_chunks(v, N, C)
    g, beta = _to_chunks(g, N, C), _to_chunks(beta, N, C)
    gc = jnp.cumsum(g, axis=-1)
    causal = jnp.tril(jnp.ones((C, C), dtype=bool))
    strict = jnp.tril(jnp.ones((C, C), dtype=bool), -1)
    diff = gc[..., :, None] - gc[..., None, :]
    decay = jnp.where(causal, jnp.exp(jnp.where(causal, diff, 0.0)), 0.0)
    kb = k * beta[..., None]
    L = jnp.where(strict, jnp.einsum('bhncd,bhnsd->bhncs', kb, k) * decay, 0.0)
    eye = jnp.eye(C, dtype=jnp.float32)
    Tm = lax.linalg.triangular_solve(eye + L, jnp.broadcast_to(eye, L.shape), left_side=True, lower=True)
    w = jnp.einsum('bhncs,bhnsd->bhncd', Tm, kb * jnp.exp(gc)[..., None])
    u = jnp.einsum('bhncs,bhnsd->bhncd', Tm, v * beta[..., None])
    A = jnp.where(causal, jnp.einsum('bhncd,bhnsd->bhncs', q, k) * decay, 0.0)
    qg = q * jnp.exp(gc)[..., None]
    kd = k * jnp.exp(gc[..., -1:] - gc)[..., None]
    gl = jnp.exp(gc[..., -1])

    def step(S, xs):
        w_i, u_i, A_i, qg_i, kd_i, gl_i = xs
        v_new = u_i - jnp.einsum('bhck,bhkv->bhcv', w_i, S)
        o_i = jnp.einsum('bhck,bhkv->bhcv', qg_i, S) + jnp.einsum('bhcs,bhsv->bhcv', A_i, v_new)
        S = S * gl_i[..., None, None] + jnp.einsum('bhck,bhcv->bhkv', kd_i, v_new)
        return S, o_i

    xs = tuple(jnp.moveaxis(t, 2, 0) for t in (w, u, A, qg, kd, gl))
    S, o = lax.scan(step, S0, xs)
    o = jnp.moveaxis(o, 0, 2)
    o = jnp.moveaxis(o, 1, 3).reshape(B, N * C, H, -1)[:, :T]
    return o, S


def _gdn_mixer(h, conv_hist, S0, w_in, conv_w, A_log, dt_bias, norm_w, w_out):
    B, T, _ = h.shape
    proj = h @ w_in
    qkv = proj[..., :QKV_DIM]
    z = proj[..., QKV_DIM:QKV_DIM + VAL_DIM]
    b_logit = proj[..., QKV_DIM + VAL_DIM:QKV_DIM + VAL_DIM + NV]
    a_logit = proj[..., QKV_DIM + VAL_DIM + NV:]
    xc = jnp.concatenate([conv_hist.astype(qkv.dtype), qkv], axis=1)
    acc = xc[:, 0:T] * conv_w[0]
    for j in range(1, CONV_W):
        acc = acc + xc[:, j:j + T] * conv_w[j]
    qkv_c = jax.nn.silu(acc).astype(jnp.float32)
    q = _l2norm(qkv_c[..., :KEY_DIM].reshape(B, T, NK, DK)) * (DK ** -0.5)
    k = _l2norm(qkv_c[..., KEY_DIM:2 * KEY_DIM].reshape(B, T, NK, DK))
    v = qkv_c[..., 2 * KEY_DIM:].reshape(B, T, NV, DV)
    q = jnp.repeat(q, NV // NK, axis=2)
    k = jnp.repeat(k, NV // NK, axis=2)
    beta = jax.nn.sigmoid(b_logit.astype(jnp.float32))
    g = -jnp.exp(A_log.astype(jnp.float32)) * jax.nn.softplus(a_logit.astype(jnp.float32) + dt_bias.astype(jnp.float32))
    o, S = _gated_delta_rule(q, k, v, g, beta, S0.astype(jnp.float32))
    zf = z.reshape(B, T, NV, DV).astype(jnp.float32)
    o = o * lax.rsqrt(jnp.mean(o * o, axis=-1, keepdims=True) + EPS) * norm_w.astype(jnp.float32) * jax.nn.silu(zf)
    out = o.reshape(B, T, VAL_DIM).astype(h.dtype) @ w_out
    return out, xc[:, -(CONV_W - 1):], S


def _pool_mixer(h, hist, w, scale):
    B, T, D = h.shape
    P = hist.shape[1]
    xc = jnp.concatenate([hist.astype(h.dtype), h], axis=1)
    xf = xc.astype(jnp.float32)
    cs = jnp.concatenate([jnp.zeros((B, 1, D), jnp.float32), jnp.cumsum(xf, axis=1)], axis=1)
    end = np.arange(T) + P + 1
    groups = []
    for gi, wlen in enumerate(POOL_WINDOWS):
        sl = slice(gi * GC, (gi + 1) * GC)
        lo_idx = np.maximum(end - wlen, 0)
        cnt = jnp.asarray((end - lo_idx)[:, None], jnp.float32)
        win_sum = cs[:, P + 1:, sl] - cs[:, lo_idx, sl]
        groups.append(win_sum / cnt - xf[:, P:, sl])
    d = jnp.stack(groups, axis=2).astype(h.dtype)
    y = jnp.einsum('btgc,gce->btge', d, w).reshape(B, T, D) * scale
    return y, xc[:, -POOL_BUF:]


def _swiglu(h, w_gu, w_down):
    gu = h @ w_gu
    return (jax.nn.silu(gu[..., :FFN_HIDDEN]) * gu[..., FFN_HIDDEN:]) @ w_down


def _trunk(x, conv_hist, S_hist, pool_hist, norm_mix_w, norm_ffn_w, final_norm_w, gdn_w_in, gdn_conv_w,
           gdn_A_log, gdn_dt_bias, gdn_norm_w, gdn_w_out, pool_w, pool_scale, ffn_w_gu, ffn_w_down):
    new_conv, new_S, new_pool = [], [], []
    for i in range(DEPTH):
        j = i // 2
        h = _rms_norm(x, norm_mix_w[i])
        if i % 2 == 0:
            out, c, S = _gdn_mixer(h, conv_hist[j], S_hist[j], gdn_w_in[j], gdn_conv_w[j], gdn_A_log[j],
                                   gdn_dt_bias[j], gdn_norm_w[j], gdn_w_out[j])
            new_conv.append(c)
            new_S.append(S)
        else:
            out, p = _pool_mixer(h, pool_hist[j], pool_w[j], pool_scale[j])
            new_pool.append(p)
        x = x + out.astype(x.dtype)
        x = x + _swiglu(_rms_norm(x, norm_ffn_w[i]), ffn_w_gu[i], ffn_w_down[i]).astype(x.dtype)
    y = _rms_norm(x, final_norm_w)
    return y, jnp.stack(new_conv), jnp.stack(new_S), jnp.stack(new_pool)


def setup_inputs(seed: int = 0) -> dict:
    key = jax.random.key(seed)
    ks = jax.random.split(key, 20)
    f32 = jnp.float32

    def nrm(k, shape, s):
        return jax.random.normal(k, shape, f32) * s

    n_pool_hist = min(POOL_BUF, PAST_LEN)
    A = jax.random.uniform(ks[8], (N_A, NV), f32, 1.0, 16.0)
    dt = jnp.exp(jax.random.uniform(ks[9], (N_A, NV), f32, math.log(1e-3), math.log(1e-1)))
    dt_bias = dt + jnp.log(-jnp.expm1(-dt))
    return {
        'x_prompt': nrm(ks[0], (BATCH, SEQ, D_MODEL), 1.0),
        'x_sample': nrm(ks[1], (DEC_BATCH, DEC_SEQ, D_MODEL), 1.0),
        'state_gdn_conv': nrm(ks[2], (N_A, DEC_BATCH, CONV_W - 1, QKV_DIM), 1.0),
        'state_gdn_S': nrm(ks[3], (N_A, DEC_BATCH, NV, DK, DV), 0.1),
        'state_pool': nrm(ks[4], (N_B, DEC_BATCH, n_pool_hist, D_MODEL), 1.0),
        'norm_mix_w': 1.0 + nrm(ks[5], (DEPTH, D_MODEL), 0.02),
        'norm_ffn_w': 1.0 + nrm(ks[6], (DEPTH, D_MODEL), 0.02),
        'final_norm_w': 1.0 + nrm(ks[7], (D_MODEL,), 0.02),
        'gdn_w_in': nrm(ks[10], (N_A, D_MODEL, IN_DIM), D_MODEL ** -0.5),
        'gdn_conv_w': nrm(ks[11], (N_A, CONV_W, QKV_DIM), CONV_W ** -0.5),
        'gdn_A_log': jnp.log(A),
        'gdn_dt_bias': dt_bias,
        'gdn_norm_w': 1.0 + nrm(ks[12], (N_A, DV), 0.02),
        'gdn_w_out': nrm(ks[13], (N_A, VAL_DIM, D_MODEL), VAL_DIM ** -0.5),
        'pool_w': nrm(ks[14], (N_B, N_GROUPS, GC, GC), GC ** -0.5),
        'pool_scale': 1.0 + nrm(ks[15], (N_B, D_MODEL), 0.02),
        'ffn_w_gu': nrm(ks[16], (DEPTH, D_MODEL, 2 * FFN_HIDDEN), D_MODEL ** -0.5),
        'ffn_w_down': nrm(ks[17], (DEPTH, FFN_HIDDEN, D_MODEL), FFN_HIDDEN ** -0.5),
    }


def reference(x_prompt, x_sample, state_gdn_conv, state_gdn_S, state_pool, norm_mix_w, norm_ffn_w,
              final_norm_w, gdn_w_in, gdn_conv_w, gdn_A_log, gdn_dt_bias, gdn_norm_w, gdn_w_out, pool_w,
              pool_scale, ffn_w_gu, ffn_w_down):
    conv0 = jnp.zeros((N_A, BATCH, CONV_W - 1, QKV_DIM), x_prompt.dtype)
    S00 = jnp.zeros((N_A, BATCH, NV, DK, DV), jnp.float32)
    pool0 = jnp.zeros((N_B, BATCH, 0, D_MODEL), x_prompt.dtype)
    y_prompt, conv_p, S_p, pool_p = _trunk(
        x_prompt, conv0, S00, pool0, norm_mix_w, norm_ffn_w, final_norm_w, gdn_w_in, gdn_conv_w,
        gdn_A_log, gdn_dt_bias, gdn_norm_w, gdn_w_out, pool_w, pool_scale, ffn_w_gu, ffn_w_down)
    y_sample, conv_s, S_s, pool_s = _trunk(
        x_sample, state_gdn_conv, state_gdn_S, state_pool, norm_mix_w, norm_ffn_w, final_norm_w, gdn_w_in,
        gdn_conv_w, gdn_A_log, gdn_dt_bias, gdn_norm_w, gdn_w_out, pool_w, pool_scale, ffn_w_gu, ffn_w_down)
    S_p = S_p.astype(state_gdn_S.dtype)
    S_s = S_s.astype(state_gdn_S.dtype)
    return (y_prompt, y_sample, conv_p, S_p, pool_p, conv_s, S_s, pool_s)
```

```cpp
#include <hip/hip_runtime.h>
#include <cstdio>
#include <cstdint>

#define LAS __attribute__((address_space(3)))
typedef unsigned short bf16_t;
typedef short bf16x8 __attribute__((ext_vector_type(8)));
typedef float f32x4 __attribute__((ext_vector_type(4)));
typedef float f32x2 __attribute__((ext_vector_type(2)));
typedef unsigned u32x4 __attribute__((ext_vector_type(4)));
typedef unsigned u32x2 __attribute__((ext_vector_type(2)));
typedef _Float16 f16_t;
typedef _Float16 f16x4 __attribute__((ext_vector_type(4)));
typedef _Float16 f16x8 __attribute__((ext_vector_type(8)));

constexpr int D = 2048, QKVD = 8192, VALD = 4096, IND = 12352, FF = 5632, NVH = 32;
constexpr int FFP = FF + 64;
constexpr int MP = 16384, MS = 128, MT = MP + MS, MPAD = 16640, NPANEL = MPAD / 256;
constexpr int NIN_PAD = 12544, PROJW = 12352;
constexpr float EPS = 1e-6f;
constexpr size_t O_CONV_P = (size_t)MT * D, O_S_P = O_CONV_P + 2 * 8 * 3 * QKVD, O_POOL_P = O_S_P + (size_t)2 * 8 * 32 * 128 * 128, O_CONV_S = O_POOL_P + 2 * 8 * 15 * D,
                 O_S_S = O_CONV_S + 2 * 8 * 3 * QKVD, O_POOL_S = O_S_S + (size_t)2 * 8 * 32 * 128 * 128;
constexpr size_t WS_CTL = 0, CTL_BYTES = 65536;
constexpr size_t WS_WIN = 1u << 20;
constexpr size_t WS_WOUT = WS_WIN + (size_t)2 * NIN_PAD * D * 2;
constexpr size_t WS_WGU = WS_WOUT + (size_t)2 * D * VALD * 2;
constexpr size_t WS_WDN = WS_WGU + (size_t)4 * 2 * FF * D * 2;
constexpr size_t WS_WPL = WS_WDN + (size_t)4 * D * FFP * 2;
constexpr size_t WS_X = WS_WPL + (size_t)2 * D * 512 * 2;
constexpr size_t WS_H = WS_X + (size_t)MPAD * D * 4;
constexpr size_t WS_PROJ = WS_H + (size_t)MPAD * D * 2;
constexpr size_t WS_LOGIT = WS_PROJ + (size_t)MPAD * PROJW * 2;
constexpr size_t WS_OG = WS_LOGIT + (size_t)MPAD * 64 * 4;
constexpr size_t WS_PART = WS_OG + (size_t)MPAD * VALD * 2;
constexpr size_t WS_END = WS_PART + (size_t)22 * 128 * D * 4;
constexpr int CW_BAR = 4096;
constexpr int RING_BYTES = 131072, LDS_BYTES = 163840, MISC_OFF = LDS_BYTES - 512;

__device__ __forceinline__ float bf2f(bf16_t b) { return __uint_as_float(((unsigned)b) << 16); }
typedef __bf16 bf16x2_t __attribute__((ext_vector_type(2)));
__device__ __forceinline__ unsigned pk2(float lo, float hi) { const f32x2 v = {lo, hi}; return __builtin_bit_cast(unsigned, __builtin_convertvector(v, bf16x2_t)); }
__device__ __forceinline__ unsigned f2bf(float f) { return pk2(f, 0.f); }
template <int CTRL> __device__ __forceinline__ float dpp_mov(float v) { return __int_as_float(__builtin_amdgcn_update_dpp(0, __float_as_int(v), CTRL, 0xf, 0xf, true)); }
__device__ __forceinline__ float row16_sum(float v) { v += dpp_mov<0xB1>(v); v += dpp_mov<0x4E>(v); v += dpp_mov<0x141>(v); v += dpp_mov<0x140>(v); return v; }
__device__ __forceinline__ float wave_sum(float v) {
    v = row16_sum(v);
    const int i = __float_as_int(v);
    return (__int_as_float(__builtin_amdgcn_readlane(i, 0)) + __int_as_float(__builtin_amdgcn_readlane(i, 16))) + (__int_as_float(__builtin_amdgcn_readlane(i, 32)) + __int_as_float(__builtin_amdgcn_readlane(i, 48)));
}
__device__ __forceinline__ float silu_f(float x) { return x * __builtin_amdgcn_rcpf(1.f + __expf(-x)); }

namespace pg8 {
#define PG8_LAS __attribute__((address_space(3)))
constexpr int BM = 256, BK = 64, HALF = 128, HTB = HALF * BK * 2  , STAGE_BYTES = 8 * HTB, NXCD = 8;

__host__ __device__ __forceinline__ int lds_byte(int r, int c) { const int st = (r >> 4) * 2 + (c >> 5), rr = r & 15, cc = c & 31, ob = rr * 64 + cc * 2; return st * 1024 + (ob ^ (((ob >> 9) & 1) << 5)); }
__host__ __device__ __forceinline__ void stage_rc(int b, int& R, int& C) { const int st = b / 1024, sb = b % 1024, swz = sb ^ (((sb >> 9) & 1) << 5); R = (st >> 1) * 16 + swz / 64; C = (st & 1) * 32 + (swz % 64) / 2; }
__host__ __device__ __forceinline__ int perm32(int rho) { const int n = rho >> 4, i = rho & 15; return 8 * (i >> 2) + 4 * n + (i & 3); }

#ifndef WGM_WIDE_V
#define WGM_WIDE_V 8
#endif
#ifndef WGM_NARROW_V
#define WGM_NARROW_V 4
#endif
constexpr int WGM_WIDE = WGM_WIDE_V, WGM_NARROW = WGM_NARROW_V;
struct Unit { int pm, pn, kt0, nkt, slice; };
struct Gemm { const bf16_t* A; const bf16_t* Bt; int lda, ldb, nM, nN, K, grp_shift, grp_k;
    __device__ __forceinline__ size_t aofs(int pn) const { return (size_t)((pn >> grp_shift) * grp_k) * 2; } };

struct StaticOrder {
    int nM, nN, nwg, G, c, WGM;
    __host__ __device__ void init(int nM_, int nN_, int G_, int c_, int wgm_ = WGM_WIDE) { nM = nM_; nN = nN_; nwg = nM * nN; G = G_; c = c_; WGM = wgm_; }
    __host__ __device__ __forceinline__ bool next(int i, Unit& u) const {
        u.pm = 0; u.pn = 0; u.kt0 = 0; u.nkt = 0; u.slice = -1;
        const long L = (long)i * G + c; if (L >= nwg) return false;
        int wgid = (int)L; { const int q = nwg / NXCD, r = nwg % NXCD, xcd = wgid % NXCD, off = wgid / NXCD; wgid = (xcd < r ? xcd * (q + 1) : r * (q + 1) + (xcd - r) * q) + off; }
        const int nig = WGM * nN, gid = wgid / nig, fm = gid * WGM, gsz = (nM - fm) < WGM ? (nM - fm) : WGM;
        u.pm = fm + ((wgid % nig) % gsz); u.pn = (wgid % nig) / gsz; u.kt0 = 0; u.nkt = 0; u.slice = -1; return true;
    }
    __device__ __forceinline__ void a_ready(const Unit&) const {}
    __device__ __forceinline__ void done(const Unit&) const {}
};

struct SplitOrder : StaticOrder {
    int nsl, slice_kt;
    __host__ __device__ __forceinline__ void init2(int nM_full, int nN_, int G_, int c_, int nkt_total, int slice_kt_, int wgm_ = WGM_NARROW) { init(nM_full, nN_, G_, c_, wgm_); slice_kt = slice_kt_; nsl = nkt_total / slice_kt_; }
    __host__ __device__ __forceinline__ bool next(int i, Unit& u) const {
        Unit t; t.pm = 0; t.pn = 0; t.kt0 = 0; t.nkt = 0; t.slice = -1;
        bool ok = StaticOrder::next(i, t);
        if (!ok) {
            const int s = (i - nwg / G) * G + c - (nwg % G);
            if (i >= nwg / G && s >= 0 && s < nN * nsl) { t.pm = nM; t.pn = s % nN; t.slice = s / nN; t.kt0 = t.slice * slice_kt; t.nkt = slice_kt; ok = true; }
        }
        u = t; return ok;
    }
};

__device__ __forceinline__ unsigned cvt_pk_bf16(float lo, float hi) { unsigned r; asm volatile("v_cvt_pk_bf16_f32 %0, %1, %2" : "=v"(r) : "v"(lo), "v"(hi)); return r; }

struct EpiResidual {
    static constexpr bool PERM = true, AFTER_DRAIN = false;
    __device__ __forceinline__ int min_stores(const Unit&, int) const { return 8; }
    f16_t* X; const float* Xin32; const float* scale; float* part;
    __device__ __forceinline__ void operator()(const f32x4 (&acc)[2][2][4][2], const Unit& u, int wr, int wc, int fr, int fq) const {
        const int row0 = u.pm * BM + wr * 64 + fr, col0 = u.pn * BM + wc * 32 + 8 * fq;
        f32x4 sv[2][2];
#pragma unroll
        for (int bj = 0; bj < 2; ++bj)
#pragma unroll
            for (int n = 0; n < 2; ++n) sv[bj][n] = scale ? *(const f32x4*)(scale + col0 + bj * HALF + n * 4) : (f32x4){1.f, 1.f, 1.f, 1.f};
        if (u.slice >= 0) {
#pragma unroll
            for (int m = 0; m < 4; ++m) { float* rowp = part + ((size_t)u.slice * 128 + wr * 64 + m * 16 + fr) * D + col0;
#pragma unroll
                for (int bj = 0; bj < 2; ++bj)
#pragma unroll
                    for (int n = 0; n < 2; ++n) *(f32x4*)(rowp + bj * HALF + n * 4) = acc[0][bj][m][n] * sv[bj][n]; }
            return;
        }
#pragma unroll
        for (int ai = 0; ai < 2; ++ai) {
            f32x4 xv[4][2][2];
            if (Xin32) {
#pragma unroll
                for (int m = 0; m < 4; ++m) { const float* rowp = Xin32 + (size_t)(row0 + ai * HALF + m * 16) * D + col0;
#pragma unroll
                    for (int bj = 0; bj < 2; ++bj)
#pragma unroll
                        for (int n = 0; n < 2; ++n) xv[m][bj][n] = *(const f32x4*)(rowp + bj * HALF + n * 4); }
            } else {
                f16x8 hv[4][2];
#pragma unroll
                for (int m = 0; m < 4; ++m) { const f16_t* rowp = X + (size_t)(row0 + ai * HALF + m * 16) * D + col0;
#pragma unroll
                    for (int bj = 0; bj < 2; ++bj) hv[m][bj] = *(const f16x8*)(rowp + bj * HALF); }
#pragma unroll
                for (int m = 0; m < 4; ++m)
#pragma unroll
                    for (int bj = 0; bj < 2; ++bj) { const f16x8 h = hv[m][bj];
                        xv[m][bj][0] = (f32x4){(float)h[0], (float)h[1], (float)h[2], (float)h[3]}; xv[m][bj][1] = (f32x4){(float)h[4], (float)h[5], (float)h[6], (float)h[7]}; }
            }
#pragma unroll
            for (int m = 0; m < 4; ++m) { f16_t* rowp = X + (size_t)(row0 + ai * HALF + m * 16) * D + col0;
#pragma unroll
                for (int bj = 0; bj < 2; ++bj) { const f16x4 a = __builtin_convertvector(xv[m][bj][0] + acc[ai][bj][m][0] * sv[bj][0], f16x4), b = __builtin_convertvector(xv[m][bj][1] + acc[ai][bj][m][1] * sv[bj][1], f16x4);
                    *(f16x8*)(rowp + bj * HALF) = (f16x8){a[0], a[1], a[2], a[3], b[0], b[1], b[2], b[3]}; } }
            asm volatile("" ::: "memory");
        }
    }
};
struct EpiNull {
    static constexpr bool PERM = true, AFTER_DRAIN = false;
    __device__ __forceinline__ int min_stores(const Unit&, int) const { return 0; }
    __device__ __forceinline__ void operator()(const f32x4 (&acc)[2][2][4][2], const Unit& u, int wr, int wc, int fr, int fq) const {
#pragma unroll
        for (int ai = 0; ai < 2; ++ai)
#pragma unroll
            for (int m = 0; m < 4; ++m)
#pragma unroll
                for (int bj = 0; bj < 2; ++bj) { asm volatile("" :: "v"(acc[ai][bj][m][0]), "v"(acc[ai][bj][m][1])); }
    }
};
struct EpiInProj {
    static constexpr bool PERM = true, AFTER_DRAIN = false;
    bf16_t* PROJ; float* LOGIT; float* conv_p; float* conv_s;
    __device__ __forceinline__ int min_stores(const Unit& u, int wc) const { return (u.pn < 48 || wc < 2) ? 16 : 0; }
    __device__ __forceinline__ void operator()(const f32x4 (&acc)[2][2][4][2], const Unit& u, int wr, int wc, int fr, int fq) const {
        const int row0 = u.pm * BM + wr * 64 + fr;
        if (u.pn < 48) {
            const int col0 = u.pn * BM + wc * 32 + 8 * fq;
#pragma unroll
            for (int ai = 0; ai < 2; ++ai)
#pragma unroll
                for (int m = 0; m < 4; ++m) { const int r = row0 + ai * HALF + m * 16;
                    float* ct = nullptr;
                    if (u.pn < 32) {
                        if (r < MP) { const int t = r & 2047; if (t >= 2045) ct = conv_p + ((size_t)(r >> 11) * 3 + (t - 2045)) * QKVD; }
                        else if (r < MT) { const int t = r & 15; if (t >= 13) ct = conv_s + ((size_t)((r - MP) >> 4) * 3 + (t - 13)) * QKVD; }
                    }
#pragma unroll
                    for (int bj = 0; bj < 2; ++bj) { const f32x4 v0 = acc[ai][bj][m][0], v1 = acc[ai][bj][m][1];
                        u32x4 w; w.x = cvt_pk_bf16(v0[0], v0[1]); w.y = cvt_pk_bf16(v0[2], v0[3]); w.z = cvt_pk_bf16(v1[0], v1[1]); w.w = cvt_pk_bf16(v1[2], v1[3]);
                        *(u32x4*)(PROJ + (size_t)r * PROJW + col0 + bj * HALF) = w;
                        if (ct) { *(f32x4*)(ct + col0 + bj * HALF) = v0; *(f32x4*)(ct + col0 + bj * HALF + 4) = v1; } } }
        } else if (wc < 2) {
#pragma unroll
            for (int ai = 0; ai < 2; ++ai)
#pragma unroll
                for (int m = 0; m < 4; ++m) { float* lp = LOGIT + (size_t)(row0 + ai * HALF + m * 16) * 64 + wc * 32 + 8 * fq;
                    *(f32x4*)lp = acc[ai][0][m][0]; *(f32x4*)(lp + 4) = acc[ai][0][m][1]; }
        }
    }
};
struct EpiSwiGLU {
    static constexpr bool PERM = true, AFTER_DRAIN = false;
    __device__ __forceinline__ int min_stores(const Unit&, int) const { return 8; }
    bf16_t* ACT; float* part;
    __device__ __forceinline__ void operator()(const f32x4 (&acc)[2][2][4][2], const Unit& u, int wr, int wc, int fr, int fq) const {
        const int row0 = u.pm * BM + wr * 64 + fr, j0 = u.pn * 128 + wc * 32 + 8 * fq;
        if (u.slice >= 0) {
#pragma unroll
            for (int m = 0; m < 4; ++m) { float* rowp = part + ((size_t)u.slice * 128 + wr * 64 + m * 16 + fr) * (2 * FF) + u.pn * BM + wc * 32 + 8 * fq;
#pragma unroll
                for (int bj = 0; bj < 2; ++bj) { *(f32x4*)(rowp + bj * HALF) = acc[0][bj][m][0]; *(f32x4*)(rowp + bj * HALF + 4) = acc[0][bj][m][1]; } }
            return;
        }
#pragma unroll
        for (int ai = 0; ai < 2; ++ai)
#pragma unroll
            for (int m = 0; m < 4; ++m) { bf16_t* rowp = ACT + (size_t)(row0 + ai * HALF + m * 16) * FFP + j0;
                f32x4 a[2];
#pragma unroll
                for (int n = 0; n < 2; ++n) { const f32x4 gv = acc[ai][0][m][n], uv = acc[ai][1][m][n];
#pragma unroll
                    for (int e = 0; e < 4; ++e) a[n][e] = gv[e] * __builtin_amdgcn_rcpf(1.f + __expf(-gv[e])) * uv[e]; }
                u32x4 w; w.x = cvt_pk_bf16(a[0][0], a[0][1]); w.y = cvt_pk_bf16(a[0][2], a[0][3]); w.z = cvt_pk_bf16(a[1][0], a[1][1]); w.w = cvt_pk_bf16(a[1][2], a[1][3]);
                *(u32x4*)rowp = w; }
    }
};

template <class Epi, class Sched, bool ALIGN_EPI = false, bool SP2 = false>
__device__ __forceinline__ void gemm_phase(PG8_LAS unsigned char* lds, const Gemm g, const Sched& S, const Epi& E, int tid_in) {
    int tid = tid_in; asm volatile("" : "+v"(tid));
    const int wid = __builtin_amdgcn_readfirstlane(tid >> 6), lane = tid & 63, wr = wid >> 2, wc = wid & 3, fr = lane & 15, fq = lane >> 4;
    const int nt_full = g.K / BK;
    unsigned voffA[2], voffB[2];
#pragma unroll
    for (int i = 0; i < 2; ++i) { int R, C; stage_rc(tid * 16 + i * 8192, R, C); const int Rb = Epi::PERM ? ((R & ~31) + perm32(R & 31)) : R;
        voffA[i] = (unsigned)(R * g.lda + C) * 2u; voffB[i] = (unsigned)(Rb * g.ldb + C) * 2u; }
    const size_t kstep = (size_t)(BK * 2);
    const size_t hstepA = (size_t)HALF * g.lda * 2, hstepB = (size_t)HALF * g.ldb * 2;
    const size_t tstepA = 2 * hstepA, tstepB = 2 * hstepB;
    const unsigned ldsw = (unsigned)wid * 1024u;
    const int aoff = lds_byte(wr * 64 + fr, fq * 8), boff = lds_byte(wc * 32 + fr, fq * 8);
#define PG8_SA(b, h) (((b) * 2 + (h)) * HTB)
#define PG8_SB(b, h) ((4 + (b) * 2 + (h)) * HTB)
#define PG8_STAGE(bufoff, gbase, voff) do { _Pragma("unroll") for (int _i = 0; _i < 2; ++_i) \
        __builtin_amdgcn_global_load_lds((const unsigned*)((const char*)(gbase) + (voff)[_i]), (PG8_LAS unsigned*)(lds + (bufoff) + ldsw + _i * 8192), 16, 0, 0); } while (0)
#define PG8_LDA(dst, b, h) do { _Pragma("unroll") for (int m = 0; m < 4; ++m) _Pragma("unroll") for (int k = 0; k < 2; ++k) dst[m][k] = *(const PG8_LAS bf16x8*)(lds + PG8_SA(b, h) + aoff + m * 2048 + k * 1024); } while (0)
#define PG8_LDB(dst, b, h) do { _Pragma("unroll") for (int n = 0; n < 2; ++n) _Pragma("unroll") for (int k = 0; k < 2; ++k) dst[n][k] = *(const PG8_LAS bf16x8*)(lds + PG8_SB(b, h) + boff + n * 2048 + k * 1024); } while (0)
#define PG8_MMA(ai, bj, At, Bt) do { __builtin_amdgcn_s_setprio(1); _Pragma("unroll") for (int m = 0; m < 4; ++m) _Pragma("unroll") for (int n = 0; n < 2; ++n) _Pragma("unroll") for (int k = 0; k < 2; ++k) \
        acc[ai][bj][m][n] = __builtin_amdgcn_mfma_f32_16x16x32_bf16(Bt[n][k], At[m][k], acc[ai][bj][m][n], 0, 0, 0); __builtin_amdgcn_s_setprio(0); } while (0)
#define PG8_WAIT_V(n) asm volatile("s_waitcnt vmcnt(" #n ")" ::: "memory")
#define PG8_WAIT_L(n) asm volatile("s_waitcnt lgkmcnt(" #n ")" ::: "memory")
#define PG8_WAIT_V8R(r) do { const int r_ = (r); asm volatile("s_cmp_lt_u32 %0, 8\n\ts_cbranch_scc1 1f\n\ts_cmp_lt_u32 %0, 16\n\ts_cbranch_scc1 2f\n\ts_waitcnt vmcnt(24)\n\ts_branch 3f\n2:\n\ts_waitcnt vmcnt(16)\n\ts_branch 3f\n1:\n\ts_waitcnt vmcnt(8)\n3:" :: "s"(r_) : "memory", "scc"); } while (0)
#define PG8_BAR __builtin_amdgcn_s_barrier()
#define PG8_SCHED __builtin_amdgcn_sched_barrier(0)
    Unit cur, nxt; int ui = 0; int relax = 0;
    if (!S.next(0, cur)) return;
    f32x4 acc[2][2][4][2];
#pragma unroll
    for (int a = 0; a < 2; ++a)
#pragma unroll
        for (int b = 0; b < 2; ++b)
#pragma unroll
            for (int m = 0; m < 4; ++m)
#pragma unroll
                for (int n = 0; n < 2; ++n) acc[a][b][m][n] = (f32x4){0.f, 0.f, 0.f, 0.f};
    bf16x8 At[4][2], B0[2][2], B1[2][2];
    const char* cA = (const char*)g.A + (size_t)cur.pm * tstepA + g.aofs(cur.pn) + (size_t)cur.kt0 * kstep; const char* cB = (const char*)g.Bt + (size_t)cur.pn * tstepB + (size_t)cur.kt0 * kstep;
    S.a_ready(cur);
    if constexpr (SP2) {
        PG8_STAGE(PG8_SB(0, 0), cB, voffB); PG8_STAGE(PG8_SB(0, 1), cB + hstepB, voffB); PG8_STAGE(PG8_SA(0, 0), cA, voffA); PG8_STAGE(PG8_SA(0, 1), cA + hstepA, voffA);
        if (wr == 1) PG8_BAR;
        PG8_WAIT_V(2); PG8_BAR;
        PG8_STAGE(PG8_SB(1, 0), cB + kstep, voffB); PG8_STAGE(PG8_SA(1, 0), cA + kstep, voffA); PG8_STAGE(PG8_SB(1, 1), cB + hstepB + kstep, voffB);
        PG8_WAIT_V(6); PG8_BAR;
    } else {
        PG8_STAGE(PG8_SB(0, 0), cB, voffB); PG8_STAGE(PG8_SA(0, 0), cA, voffA); PG8_STAGE(PG8_SB(0, 1), cB + hstepB, voffB); PG8_STAGE(PG8_SA(0, 1), cA + hstepA, voffA);
        if (wr == 1) PG8_BAR;
        PG8_WAIT_V(4); PG8_BAR;
        PG8_STAGE(PG8_SB(1, 0), cB + kstep, voffB); PG8_STAGE(PG8_SA(1, 0), cA + kstep, voffA); PG8_STAGE(PG8_SB(1, 1), cB + hstepB + kstep, voffB);
        PG8_WAIT_V(6); PG8_BAR;
    }
    for (;;) {
        const bool has_next = S.next(ui + 1, nxt);
        const char* nA = has_next ? (const char*)g.A + (size_t)nxt.pm * tstepA + g.aofs(nxt.pn) + (size_t)nxt.kt0 * kstep : cA; const char* nB = has_next ? (const char*)g.Bt + (size_t)nxt.pn * tstepB + (size_t)nxt.kt0 * kstep : cB;
        const int nt = cur.nkt > 0 ? cur.nkt : nt_full;
        int rl = relax; asm volatile("" : "+s"(rl));
        for (int t = 0; t < nt; t += 2) {
            const bool last = (t == nt - 2);
            const char* a1 = cA + (size_t)(t + 1) * kstep;
            const char* a2 = last ? nA : cA + (size_t)(t + 2) * kstep; const char* b2 = last ? nB : cB + (size_t)(t + 2) * kstep;
            const char* a3 = a2 + kstep; const char* b3 = b2 + kstep;
            if (last && has_next) S.a_ready(nxt);
            if constexpr (SP2) {
            PG8_LDB(B0, 0, 0); PG8_LDB(B1, 0, 1); PG8_SCHED; PG8_LDA(At, 0, 0); PG8_STAGE(PG8_SA(1, 1), a1 + hstepA, voffA);
            PG8_WAIT_V8R(rl);
            PG8_WAIT_L(0); PG8_BAR; PG8_MMA(0, 0, At, B0); PG8_MMA(0, 1, At, B1); PG8_BAR; PG8_SCHED;
            PG8_LDA(At, 0, 1); PG8_STAGE(PG8_SB(0, 0), b2, voffB); PG8_STAGE(PG8_SB(0, 1), b2 + hstepB, voffB); PG8_STAGE(PG8_SA(0, 0), a2, voffA);
            PG8_WAIT_V8R(rl);
            PG8_WAIT_L(0); PG8_BAR; PG8_MMA(1, 0, At, B0); PG8_MMA(1, 1, At, B1); PG8_BAR; PG8_SCHED;
            asm volatile("s_mov_b32 %0, 0" : "=s"(rl));
            PG8_LDB(B0, 1, 0); PG8_LDB(B1, 1, 1); PG8_SCHED; PG8_LDA(At, 1, 0); PG8_STAGE(PG8_SA(0, 1), a2 + hstepA, voffA);
            PG8_WAIT_V(8); PG8_WAIT_L(0); PG8_BAR; PG8_MMA(0, 0, At, B0); PG8_MMA(0, 1, At, B1); PG8_BAR; PG8_SCHED;
            PG8_LDA(At, 1, 1); PG8_STAGE(PG8_SB(1, 0), b3, voffB); PG8_STAGE(PG8_SB(1, 1), b3 + hstepB, voffB); PG8_STAGE(PG8_SA(1, 0), a3, voffA);
            PG8_WAIT_V(8); PG8_WAIT_L(0); PG8_BAR; PG8_MMA(1, 0, At, B0); PG8_MMA(1, 1, At, B1); PG8_BAR; PG8_SCHED;
            } else {
            PG8_LDB(B0, 0, 0); PG8_SCHED; PG8_LDA(At, 0, 0); PG8_STAGE(PG8_SA(1, 1), a1 + hstepA, voffA);
            PG8_WAIT_L(8); PG8_BAR; PG8_WAIT_L(0); PG8_MMA(0, 0, At, B0); PG8_BAR; PG8_SCHED;
            PG8_LDB(B1, 0, 1); PG8_STAGE(PG8_SB(0, 0), b2, voffB);
            PG8_BAR; PG8_WAIT_L(0); PG8_MMA(0, 1, At, B1); PG8_BAR;
            PG8_LDA(At, 0, 1); PG8_STAGE(PG8_SA(0, 0), a2, voffA);
            PG8_BAR; PG8_WAIT_L(0); PG8_MMA(1, 0, At, B0); PG8_BAR; PG8_SCHED;
            PG8_STAGE(PG8_SB(0, 1), b2 + hstepB, voffB);
            PG8_WAIT_V(6); PG8_BAR; PG8_MMA(1, 1, At, B1); PG8_BAR;
            PG8_LDB(B0, 1, 0); PG8_SCHED; PG8_LDA(At, 1, 0); PG8_STAGE(PG8_SA(0, 1), a2 + hstepA, voffA);
            PG8_WAIT_L(8); PG8_BAR; PG8_WAIT_L(0); PG8_MMA(0, 0, At, B0); PG8_BAR; PG8_SCHED;
            PG8_LDB(B1, 1, 1); PG8_STAGE(PG8_SB(1, 0), b3, voffB);
            PG8_BAR; PG8_WAIT_L(0); PG8_MMA(0, 1, At, B1); PG8_BAR;
            PG8_LDA(At, 1, 1); PG8_STAGE(PG8_SA(1, 0), a3, voffA);
            PG8_BAR; PG8_WAIT_L(0); PG8_MMA(1, 0, At, B0); PG8_BAR; PG8_SCHED;
            PG8_STAGE(PG8_SB(1, 1), b3 + hstepB, voffB);
            PG8_WAIT_V(6); PG8_BAR; PG8_MMA(1, 1, At, B1); PG8_BAR;
            }
        }
        if constexpr (ALIGN_EPI) { if (wr == 0) PG8_BAR; }
        if constexpr (!Epi::AFTER_DRAIN) { E(acc, cur, wr, wc, fr, fq); S.done(cur); relax = SP2 ? E.min_stores(cur, wc) : 0; }
        if (!has_next) break;
#pragma unroll
        for (int a = 0; a < 2; ++a)
#pragma unroll
            for (int b = 0; b < 2; ++b)
#pragma unroll
                for (int m = 0; m < 4; ++m)
#pragma unroll
                    for (int n = 0; n < 2; ++n) acc[a][b][m][n] = (f32x4){0.f, 0.f, 0.f, 0.f};
        cur = nxt; cA = nA; cB = nB; ++ui;
        if constexpr (ALIGN_EPI) { if (wr == 1) PG8_BAR; }
    }
    PG8_WAIT_V(0);
    if constexpr (!ALIGN_EPI) { if (wr == 0) PG8_BAR; }
    PG8_BAR;
    if constexpr (Epi::AFTER_DRAIN) { E.fused(acc, cur, wr, wc, fr, fq, lds, wid, lane); S.done(cur); }
#undef PG8_SA
#undef PG8_SB
#undef PG8_STAGE
#undef PG8_LDA
#undef PG8_LDB
#undef PG8_MMA
#undef PG8_WAIT_V
#undef PG8_WAIT_L
#undef PG8_WAIT_V8R
#undef PG8_BAR
#undef PG8_SCHED
}
}

#define XB_TMO      128
#define XB_XCNT(j)  (256  + 64 * (j))
#define XB_XSUB(j)  (1280 + 64 * (j))
#define XB_XGEN(j)  (2304 + 64 * (j))
#define XB_TOP      3328
#define XB_TOPGEN   3392
#define XCD_BAR_WORDS 3456
#define XB_SPIN_CAP (1u << 18)

__device__ __forceinline__ unsigned xb_ld(unsigned* p)              { return __hip_atomic_load(p, __ATOMIC_RELAXED, __HIP_MEMORY_SCOPE_AGENT); }
__device__ __forceinline__ unsigned xb_add(unsigned* p, unsigned v) { return __hip_atomic_fetch_add(p, v, __ATOMIC_RELAXED, __HIP_MEMORY_SCOPE_AGENT); }
__device__ __forceinline__ unsigned xb_xcc_id() { return (unsigned)__builtin_amdgcn_s_getreg((3 << 11) | 20) & 0xFu; }
#define XB_SPIN(cond, bar) do { unsigned _sp = 0; while (cond) { __builtin_amdgcn_s_sleep(1); \
    if ((++_sp & 255u) == 0u) { if (xb_ld(&(bar)[XB_TMO])) break; if (_sp > XB_SPIN_CAP) { atomicAdd(&(bar)[XB_TMO], 1u); break; } } } } while (0)

struct XcdBarrier {
    unsigned* bar; unsigned x;
    volatile LAS unsigned* st;
};

__device__ __forceinline__ XcdBarrier xcd_barrier_post(unsigned* bar, volatile LAS unsigned* st) {
    XcdBarrier b; b.bar = bar; b.x = xb_xcc_id(); b.st = st;
    if (threadIdx.x == 0) (void)xb_add(&bar[XB_XCNT(b.x)], 1u);
    return b;
}
__device__ __forceinline__ void xcd_barrier_complete(unsigned* bar, unsigned x, unsigned& nloc, unsigned& nx) {
    const unsigned G = gridDim.x * gridDim.y * gridDim.z;
    unsigned sum, cnt, mine, sp = 0u;
    for (;;) {
        sum = 0u; cnt = 0u; mine = 0u;
#pragma unroll
        for (unsigned j = 0; j < 16; ++j) { const unsigned c = xb_ld(&bar[XB_XCNT(j)]); sum += c; cnt += (c > 0u) ? 1u : 0u; mine = (j == x) ? c : mine; }
        if (sum == G) break;
        __builtin_amdgcn_s_sleep(1);
        if ((++sp & 255u) == 0u) { if (xb_ld(&bar[XB_TMO])) break; if (sp > XB_SPIN_CAP) { atomicAdd(&bar[XB_TMO], 1u); break; } }
    }
    nloc = mine > 0u ? mine : 1u; nx = cnt > 0u ? cnt : 1u;
}

__device__ __forceinline__ void xcd_barrier(const XcdBarrier& b, int tid_) {
    asm volatile("s_waitcnt vmcnt(0)" ::: "memory");
    __syncthreads();
    if (tid_ == 0) {
        unsigned* bar = b.bar;
        __builtin_amdgcn_s_waitcnt(0);
        unsigned nloc = b.st[0], nx = b.st[1];
        if (nloc == 0u) { xcd_barrier_complete(bar, b.x, nloc, nx); b.st[0] = nloc; b.st[1] = nx; }
        const unsigned old = xb_add(&bar[XB_XSUB(b.x)], 1u);
        const unsigned gen = old / nloc;
        if (old + 1u == (gen + 1u) * nloc) {
            __builtin_amdgcn_fence(__ATOMIC_RELEASE, "agent");
            asm volatile("s_waitcnt vmcnt(0)" ::: "memory");
            const unsigned og = xb_add(&bar[XB_TOP], 1u);
            const unsigned tg = og / nx;
            if (og + 1u == (tg + 1u) * nx) xb_add(&bar[XB_TOPGEN], 1u);
            else XB_SPIN(xb_ld(&bar[XB_TOPGEN]) == tg, bar);
            __builtin_amdgcn_fence(__ATOMIC_ACQUIRE, "agent");
            xb_add(&bar[XB_XGEN(b.x)], 1u);
            asm volatile("s_waitcnt vmcnt(0)" ::: "memory");
        } else {
            XB_SPIN(xb_ld(&bar[XB_XGEN(b.x)]) == gen, bar);
            __builtin_amdgcn_fence(__ATOMIC_ACQUIRE, "agent");
            asm volatile("s_waitcnt vmcnt(0)" ::: "memory");
        }
    }
    __syncthreads();
}

#define KARG(T, byteoff) (*(T const volatile __attribute__((address_space(4)))*)((const __attribute__((address_space(4))) char*)__builtin_amdgcn_kernarg_segment_ptr() + (byteoff)))
struct WJob { const float* W; bf16_t* WT; int N, Kd, mode, k0, n0; bool ok; };
constexpr int I_IN = (D / 64) * (IND / 64), I_OUT = (VALD / 64) * (D / 64), I_GU = (D / 64) * (2 * FF / 64), I_DN = (FF / 64) * (D / 64), I_PL = 8 * 8;
constexpr int WL_P0 = I_IN;
constexpr int WL_SEQ = I_IN + 2 * I_OUT + 4 * I_GU + 4 * I_DN + 8 * I_PL;
constexpr int SIDE_SLOTS = 65;
static_assert(SIDE_SLOTS * 256 == I_OUT + 2 * I_GU + I_DN + 8 * I_PL, "the first recurrence phase covers exactly the first five groups of the sequence");
__device__ __forceinline__ WJob wjob_decode(int list, int r) {
    WJob j; j.ok = (r >= 0); j.mode = 0; j.N = IND; j.Kd = D; j.k0 = 0; j.n0 = 0;
    int karg = 64; size_t src = 0, dst = WS_WIN;
#define WJ_IN(jj)   do { karg = 64; src = (size_t)(jj) * D * IND; j.N = IND; dst = WS_WIN + (size_t)(jj) * NIN_PAD * D * 2; j.Kd = D; } while (0)
#define WJ_OUT(jj)  do { karg = 104; src = (size_t)(jj) * VALD * D; j.N = D; dst = WS_WOUT + (size_t)(jj) * D * VALD * 2; j.Kd = VALD; } while (0)
#define WJ_GU(ii)   do { karg = 128; src = (size_t)(ii) * D * 2 * FF; j.N = 2 * FF; dst = WS_WGU + (size_t)(ii) * 2 * FF * D * 2; j.Kd = D; j.mode = 1; } while (0)
#define WJ_DN(ii)   do { karg = 136; src = (size_t)(ii) * FF * D; j.N = D; dst = WS_WDN + (size_t)(ii) * D * FFP * 2; j.Kd = FFP; } while (0)
#define WJ_PL(ii)   do { karg = 112; src = (size_t)(ii) * 512 * 512; j.N = 512; dst = WS_WPL + (size_t)(ii) * 512 * 512 * 2; j.Kd = 512; } while (0)
    if (list == 0) {
        if (r < I_IN) { WJ_IN(0); } else j.ok = false;
    } else {
        if (r < I_OUT) { WJ_OUT(0); }
        else if ((r -= I_OUT) < I_GU) { WJ_GU(0); }
        else if ((r -= I_GU) < I_DN) { WJ_DN(0); }
        else if ((r -= I_DN) < 8 * I_PL) { const int ii = r / I_PL; r -= ii * I_PL; WJ_PL(ii); }
        else if ((r -= 8 * I_PL) < I_GU) { WJ_GU(1); }
        else if ((r -= I_GU) < I_OUT) { WJ_OUT(1); }
        else if ((r -= I_OUT) < I_GU) { WJ_GU(2); }
        else if ((r -= I_GU) < I_DN) { WJ_DN(2); }
        else if ((r -= I_DN) < I_GU) { WJ_GU(3); }
        else if ((r -= I_GU) < I_DN) { WJ_DN(3); }
        else if ((r -= I_DN) < I_DN) { WJ_DN(1); }
        else if ((r -= I_DN) < I_IN) { WJ_IN(1); }
        else j.ok = false;
    }
#undef WJ_IN
#undef WJ_OUT
#undef WJ_GU
#undef WJ_DN
#undef WJ_PL
    j.W = KARG(const float*, karg) + src; j.WT = (bf16_t*)(KARG(unsigned char*, 152) + dst);
    if (j.ok) { const int nblk = j.N / 64, kb = r / nblk, nb = r % nblk; j.k0 = 64 * kb; j.n0 = 64 * nb; }
    return j;
}
__device__ __forceinline__ int wjob_row(int n, int mode) {
    if (mode == 1) { const int jj = n < FF ? n : n - FF; return (jj >> 7) * 256 + (jj & 127) + (n < FF ? 0 : 128); }
    return n;
}

__device__ __forceinline__ void transpose_item(const float* __restrict__ W, int N, bf16_t* __restrict__ WT, int Kd, int k0, int n0, int mode, LAS float* scr, int lane) {
    float t[64];
#pragma unroll
    for (int i = 0; i < 64; ++i) t[i] = W[(size_t)(k0 + i) * N + n0 + lane];
#pragma unroll
    for (int i = 0; i < 64; ++i) scr[i * 65 + lane] = t[i];
    asm volatile("s_waitcnt lgkmcnt(0)" ::: "memory");
    const int c = lane & 7;
#pragma unroll
    for (int j = 0; j < 8; ++j) { const int n = (lane >> 3) + 8 * j; const LAS float* s = scr + (8 * c) * 65 + n;
        u32x4 o; o.x = pk2(s[0 * 65], s[1 * 65]); o.y = pk2(s[2 * 65], s[3 * 65]); o.z = pk2(s[4 * 65], s[5 * 65]); o.w = pk2(s[6 * 65], s[7 * 65]);
        int nn = n0 + n; if (mode == 1) { const int jj = nn < FF ? nn : nn - FF; nn = (jj >> 7) * 256 + (jj & 127) + (nn < FF ? 0 : 128); }
        *(u32x4*)(WT + (size_t)nn * Kd + k0 + 8 * c) = o; }
    asm volatile("s_waitcnt lgkmcnt(0)" ::: "memory");
}
__device__ __forceinline__ void transpose_matrix(const float* W, int K, int N, bf16_t* WT, int mode, LAS float* scr, int gw, int ngw, int lane) {
    const int nblk = N / 64, items = (K / 64) * nblk;
    for (int it = gw; it < items; it += ngw) { const int kb = it / nblk, nb = it % nblk; transpose_item(W, N, WT, K, 64 * kb, 64 * nb, mode, scr, lane); }
}

template <int MODE>
__device__ __forceinline__ void norm_row(f16_t* __restrict__ X, const float* __restrict__ w, bf16_t* __restrict__ H, float* __restrict__ out_a, float* __restrict__ out_b, int lane,
                                         const float* __restrict__ part, int nsl, int m, f16x8 h0, f16x8 h1, f16x8 h2, f16x8 h3) {
        if (m >= MT) { if (MODE != 2) {
#pragma unroll
                for (int j = 0; j < 8; ++j) *(u32x2*)(H + (size_t)m * D + 4 * (lane + 64 * j)) = (u32x2){0u, 0u}; }
            return; }
#define VI(j) (2 * (lane + 64 * ((j) >> 1)) + ((j) & 1))
        f32x4 v[8]; float ss = 0.f;
        if (MODE == 3) {
            const f32x4* xr = (const f32x4*)(m < MP ? out_a + (size_t)m * D : out_b + (size_t)(m - MP) * D);
#pragma unroll
            for (int j = 0; j < 8; ++j) v[j] = xr[VI(j)];
            if (m >= MP) {
#pragma unroll
                for (int jj = 0; jj < 4; ++jj) { const f16x4 a = __builtin_convertvector(v[2 * jj], f16x4), b = __builtin_convertvector(v[2 * jj + 1], f16x4);
                    ((f16x8*)(X + (size_t)m * D))[lane + 64 * jj] = (f16x8){a[0], a[1], a[2], a[3], b[0], b[1], b[2], b[3]}; }
            }
        } else {
            const f16x8 h[4] = {h0, h1, h2, h3};
#pragma unroll
            for (int jj = 0; jj < 4; ++jj) { v[2 * jj] = (f32x4){(float)h[jj][0], (float)h[jj][1], (float)h[jj][2], (float)h[jj][3]}; v[2 * jj + 1] = (f32x4){(float)h[jj][4], (float)h[jj][5], (float)h[jj][6], (float)h[jj][7]}; }
        }
        if (nsl > 0 && m >= MP) {
            const size_t sstep = (size_t)128 * D / 4;
            int s = 0;
            for (; s + 4 <= nsl; s += 4) {
                const f32x4* pr = (const f32x4*)(part + ((size_t)s * 128 + (m - MP)) * D);
                f32x4 t0[8], t1[8], t2[8], t3[8];
#pragma unroll
                for (int j = 0; j < 8; ++j) { t0[j] = pr[VI(j)]; t1[j] = pr[sstep + VI(j)]; t2[j] = pr[2 * sstep + VI(j)]; t3[j] = pr[3 * sstep + VI(j)]; }
#pragma unroll
                for (int j = 0; j < 8; ++j) v[j] = v[j] + ((t0[j] + t1[j]) + (t2[j] + t3[j])); }
            for (; s < nsl; s += 2) {
                const f32x4* pr = (const f32x4*)(part + ((size_t)s * 128 + (m - MP)) * D);
                f32x4 t0[8], t1[8];
#pragma unroll
                for (int j = 0; j < 8; ++j) { t0[j] = pr[VI(j)]; t1[j] = pr[sstep + VI(j)]; }
#pragma unroll
                for (int j = 0; j < 8; ++j) v[j] = v[j] + (t0[j] + t1[j]); }
#pragma unroll
            for (int jj = 0; jj < 4; ++jj) { const f16x4 a = __builtin_convertvector(v[2 * jj], f16x4), b = __builtin_convertvector(v[2 * jj + 1], f16x4);
                const f16x8 hx = (f16x8){a[0], a[1], a[2], a[3], b[0], b[1], b[2], b[3]};
                ((f16x8*)(X + (size_t)m * D))[lane + 64 * jj] = hx;
                v[2 * jj] = __builtin_convertvector(a, f32x4); v[2 * jj + 1] = __builtin_convertvector(b, f32x4); }
        }
#pragma unroll
        for (int j = 0; j < 8; ++j) ss += (v[j][0] * v[j][0] + v[j][1] * v[j][1]) + (v[j][2] * v[j][2] + v[j][3] * v[j][3]);
        ss = wave_sum(ss);
        const float r = rsqrtf(ss * (1.f / D) + EPS);
        float* tail = nullptr;
        if (MODE == 1) { if (m < MP) { const int t = m & 2047; if (t >= 2033) tail = out_a + ((size_t)(m >> 11) * 15 + (t - 2033)) * D; }
                         else { const int t = (m - MP) & 15; if (t >= 1) tail = out_b + ((size_t)((m - MP) >> 4) * 15 + (t - 1)) * D; } }
        if (MODE == 2) tail = out_a + (size_t)m * D;
#pragma unroll
        for (int jj = 0; jj < 4; ++jj) { const f32x4 w0 = ((const f32x4*)w)[VI(2 * jj)], w1 = ((const f32x4*)w)[VI(2 * jj + 1)]; const f32x4 y0 = v[2 * jj] * r * w0, y1 = v[2 * jj + 1] * r * w1;
            if (MODE != 2) { u32x4 o; o.x = pk2(y0[0], y0[1]); o.y = pk2(y0[2], y0[3]); o.z = pk2(y1[0], y1[1]); o.w = pk2(y1[2], y1[3]); *(u32x4*)(H + (size_t)m * D + 8 * (lane + 64 * jj)) = o; }
            if ((MODE == 1 || MODE == 2) && tail) { *(f32x4*)(tail + 4 * VI(2 * jj)) = y0; *(f32x4*)(tail + 4 * VI(2 * jj + 1)) = y1; } }
#undef VI
}
template <int MODE>
__device__ __forceinline__ void norm_phase(f16_t* __restrict__ X, const float* __restrict__ w, bf16_t* __restrict__ H, float* __restrict__ out_a, float* __restrict__ out_b, int gw, int ngw, int lane,
                                           const float* __restrict__ part, int nsl) {
    const bool rebal = (ngw == 2048);
    const int kmax = rebal ? 10 : (MPAD + ngw - 1) / ngw;
    auto row_of = [&](int k) -> int {
        if (!rebal) { const int m = gw + k * ngw; return m < MPAD ? m : -1; }
        if (k == 0) return gw < 256 ? MP + gw : -1;
        if (k <= 8) return gw >= 128 ? gw + 2048 * (k - 1) : -1;
        if (gw < 128 || gw >= 1152) return -1;
        const int e = gw - 128; return (e & 127) + 2048 * (e >> 7);
    };
    int k = 0, m = -1;
    for (; k < kmax; ++k) { m = row_of(k); if (m >= 0) break; }
    f16x8 h[4] = {};
    if (MODE != 3 && m >= 0 && m < MT) {
#pragma unroll
        for (int jj = 0; jj < 4; ++jj) h[jj] = ((const f16x8*)(X + (size_t)m * D))[lane + 64 * jj];
    }
    while (m >= 0) {
        int kn = k + 1, mn = -1;
        for (; kn < kmax; ++kn) { mn = row_of(kn); if (mn >= 0) break; }
        f16x8 hn[4] = {h[0], h[1], h[2], h[3]};
        if (MODE != 3 && mn >= 0 && mn < MT) {
#pragma unroll
            for (int jj = 0; jj < 4; ++jj) hn[jj] = ((const f16x8*)(X + (size_t)mn * D))[lane + 64 * jj];
        }
        const int m_ = m; const f16x8 h0 = h[0], h1 = h[1], h2 = h[2], h3 = h[3];
        h[0] = hn[0]; h[1] = hn[1]; h[2] = hn[2]; h[3] = hn[3]; m = mn; k = kn;
        norm_row<MODE>(X, w, H, out_a, out_b, lane, part, nsl, m_, h0, h1, h2, h3);
    }
}


__device__ __forceinline__ void swiglu_reduce_phase(const float* __restrict__ part, int nsl, bf16_t* __restrict__ ACT, int gw, int ngw, int lane) {
    constexpr int NB = FF / 512;
    for (int it = gw; it < 256 * NB; it += ngw) {
        const int r = it / NB, blk = it % NB, j0 = blk * 512 + lane * 8;
        u32x4 w = (u32x4){0u, 0u, 0u, 0u};
        if (r < MS) {
            f32x4 a[4]; a[0] = a[1] = a[2] = a[3] = (f32x4){0.f, 0.f, 0.f, 0.f};
            for (int s = 0; s < nsl; s += 4) {
                f32x4 t[4][4];
#pragma unroll
                for (int k = 0; k < 4; ++k) { const f32x4* p = (const f32x4*)(part + ((size_t)(s + k) * 128 + r) * (2 * FF) + (j0 >> 7) * 256 + (j0 & 127));
                    t[k][0] = p[0]; t[k][1] = p[32]; t[k][2] = p[1]; t[k][3] = p[33]; }
#pragma unroll
                for (int i = 0; i < 4; ++i) a[i] = a[i] + ((t[0][i] + t[1][i]) + (t[2][i] + t[3][i])); }
            float o[8];
#pragma unroll
            for (int e = 0; e < 4; ++e) { o[e] = silu_f(a[0][e]) * a[1][e]; o[4 + e] = silu_f(a[2][e]) * a[3][e]; }
            w.x = pk2(o[0], o[1]); w.y = pk2(o[2], o[3]); w.z = pk2(o[4], o[5]); w.w = pk2(o[6], o[7]);
        }
        *(u32x4*)(ACT + (size_t)(MP + r) * FFP + j0) = w;
    }
}

__device__ __forceinline__ f32x4 bf4_to_f32(u32x2 q) { return (f32x4){__uint_as_float(q.x << 16), __uint_as_float(q.x & 0xffff0000u), __uint_as_float(q.y << 16), __uint_as_float(q.y & 0xffff0000u)}; }
template <int W>
__device__ __forceinline__ void pool_run(const bf16_t* __restrict__ H, bf16_t* __restrict__ DP, int row0, int tpos0, int c) {
    f32x4 prev[16], cur[16];
#pragma unroll
    for (int i = 0; i < 16; ++i) prev[i] = (f32x4){0.f, 0.f, 0.f, 0.f};
    if (tpos0 > 0) {
#pragma unroll
        for (int i = 16 - (W - 1); i < 16; ++i) prev[i] = bf4_to_f32(*(const u32x2*)(H + (size_t)(row0 - 16 + i) * D + c));
    }
    u32x2 nraw[16];
#pragma unroll
    for (int i = 0; i < 16; ++i) nraw[i] = *(const u32x2*)(H + (size_t)(row0 + i) * D + c);
#pragma unroll 1
    for (int g = 0; g < 4; ++g) {
#pragma unroll
        for (int i = 0; i < 16; ++i) cur[i] = bf4_to_f32(nraw[i]);
        if (g + 1 < 4) {
#pragma unroll
            for (int i = 0; i < 16; ++i) nraw[i] = *(const u32x2*)(H + (size_t)(row0 + 16 * (g + 1) + i) * D + c);
        }
        f32x4 S = (f32x4){0.f, 0.f, 0.f, 0.f};
#pragma unroll
        for (int i = 1; i < W; ++i) S = S + prev[16 - i];
#pragma unroll
        for (int tl = 0; tl < 16; ++tl) {
            S = S + cur[tl];
            const int t = tpos0 + 16 * g + tl; const int cnt = (t + 1) < W ? (t + 1) : W;
            const f32x4 dd = S * (1.f / (float)cnt) - cur[tl];
            u32x2 o; o.x = pk2(dd[0], dd[1]); o.y = pk2(dd[2], dd[3]);
            *(u32x2*)(DP + (size_t)(row0 + 16 * g + tl) * D + c) = o;
            S = S - ((tl - W + 1 >= 0) ? cur[(tl - W + 1 >= 0) ? (tl - W + 1) : 0] : prev[(tl - W + 1 >= 0) ? 0 : (16 + tl - W + 1)]);
        }
#pragma unroll
        for (int i = 16 - (W - 1); i < 16; ++i) prev[i] = cur[i];
    }
}
template <int W>
__device__ __forceinline__ void pool_row_sample(const bf16_t* __restrict__ H, const float* __restrict__ hist, bf16_t* __restrict__ DP, int m, int c) {
    const int b = (m - MP) >> 4, t = (m - MP) & 15, base = MP + b * 16, end = t + 16;
    f32x4 S = (f32x4){0.f, 0.f, 0.f, 0.f}, me = S;
#pragma unroll
    for (int i = 0; i < W; ++i) { const int p = end - W + i;
        const f32x4 xv = (p < 15) ? *(const f32x4*)(hist + ((size_t)b * 15 + p) * D + c) : bf4_to_f32(*(const u32x2*)(H + (size_t)(base + p - 15) * D + c));
        S = S + xv; me = xv; }
    const f32x4 dd = S * (1.f / (float)W) - me;
    u32x2 o; o.x = pk2(dd[0], dd[1]); o.y = pk2(dd[2], dd[3]);
    *(u32x2*)(DP + (size_t)m * D + c) = o;
}
__device__ __forceinline__ void pool_phase(const bf16_t* __restrict__ H, const float* __restrict__ hist, bf16_t* __restrict__ DP, int bid, int G, int tid) {
    const int c = tid * 4, gi = __builtin_amdgcn_readfirstlane(tid >> 7);
    for (int run = bid; run < MP / 64; run += G) {
        const int row0 = run * 64, tpos0 = (run & 31) * 64;
        if (gi == 0) pool_run<2>(H, DP, row0, tpos0, c); else if (gi == 1) pool_run<4>(H, DP, row0, tpos0, c); else if (gi == 2) pool_run<8>(H, DP, row0, tpos0, c); else pool_run<16>(H, DP, row0, tpos0, c);
    }
    for (int m = MP + bid; m < MPAD; m += G) {
        if (m >= MT) { *(u32x2*)(DP + (size_t)m * D + c) = (u32x2){0u, 0u}; continue; }
        if (gi == 0) pool_row_sample<2>(H, hist, DP, m, c); else if (gi == 1) pool_row_sample<4>(H, hist, DP, m, c); else if (gi == 2) pool_row_sample<8>(H, hist, DP, m, c); else pool_row_sample<16>(H, hist, DP, m, c);
    }
}

#ifndef PROBE
#define PROBE 0
#endif
#define RREP(k) _Pragma("unroll") for (int rrep_ = 0; rrep_ < ((PROBE) == (k) ? 2 : 1); ++rrep_)
constexpr int R_SET = 37888;
constexpr int R_KR = 0, R_VT = 8704, R_QR = 18944, R_KT = 27648;
constexpr int R_OB = 0;
constexpr int R_WR = 2 * R_SET;
constexpr int R_VN = R_WR + 8704, R_VN2 = R_VN + 10240;
constexpr int R_ST = R_VN2 + 10240;
constexpr int R_TM1 = R_ST + 34816, R_TM2 = R_TM1 + 2560, R_AM = R_TM2 + 2560;
constexpr int R_LD = R_AM + 2560;
constexpr int R_L10 = R_LD + 2048, R_TT0 = R_L10 + 768, R_T11 = R_TT0 + 768, R_M1 = R_T11 + 768;
constexpr int R_G = R_M1 + 768;
constexpr int R_CW = R_G + 2048;
constexpr int R_END = R_CW + 6144;
static_assert(R_END <= LDS_BYTES - 512 && R_OB + 16896 <= R_QR, "R phase LDS map");

__device__ __forceinline__ f32x4 mfma16(bf16x8 a, bf16x8 b, f32x4 c) { return __builtin_amdgcn_mfma_f32_16x16x32_bf16(a, b, c, 0, 0, 0); }
__device__ __forceinline__ u32x2 pack4(f32x4 v) { u32x2 r; r.x = pk2(v[0], v[1]); r.y = pk2(v[2], v[3]); return r; }
#define R_LDSFENCE() asm volatile("s_waitcnt lgkmcnt(0)" ::: "memory")

__device__ __forceinline__ void rec_stream(LAS unsigned char* lds, const bf16_t* __restrict__ PROJ, const float* __restrict__ LOGIT, size_t row0, int T, int hv,
                                           const float* __restrict__ hist, const float* __restrict__ cw, const float* __restrict__ S0, float Aneg, float dtb,
                                           const float* __restrict__ nw, bf16_t* __restrict__ OG, float* __restrict__ Sout, int tid,
                                           int side_item0, int side_stride) {
    asm volatile("" : "+v"(tid));
    const int wave = __builtin_amdgcn_readfirstlane(tid >> 6), lane = tid & 63, hk = hv >> 1;
    int fr = lane & 15, fq = lane >> 4;
#define R_OPAQUE() do { int l_ = lane; asm volatile("" : "+v"(l_)); fr = l_ & 15; fq = l_ >> 4; } while (0)
    const bf16x8 zero8 = (bf16x8){0, 0, 0, 0, 0, 0, 0, 0};
    const __amdgpu_buffer_rsrc_t rs_s0 = __builtin_amdgcn_make_buffer_rsrc((void*)S0, 0, S0 ? 65536 : 0, 0x00020000);
    const __amdgpu_buffer_rsrc_t rs_so = __builtin_amdgcn_make_buffer_rsrc((void*)Sout, 0, 65536, 0x00020000);
    const int vo_s = ((4 * fq) * 128 + 16 * wave + fr) * 4;
    f32x4 Sacc[8];
#pragma unroll
    for (int i = 0; i < 8; ++i)
#pragma unroll
        for (int r = 0; r < 4; ++r) Sacc[i][r] = __uint_as_float(__builtin_amdgcn_raw_buffer_load_b32(rs_s0, vo_s, (16 * i + r) * 512, 0));
#pragma unroll
    for (int i = 0; i < 8; ++i) *(LAS u32x2*)(lds + R_ST + (16 * wave + fr) * 272 + (16 * i + 4 * fq) * 2) = pack4(Sacc[i]);
    __builtin_amdgcn_s_waitcnt(0x0F70);
    if (tid < 48) { const int which = tid >> 4, c = tid & 15; LAS unsigned char* p = lds + (which == 0 ? R_AM : which == 1 ? R_TM1 : R_TM2) + c * 80 + 32;
        *(LAS u32x4*)p = (u32x4){0u, 0u, 0u, 0u}; *(LAS u32x4*)(p + 16) = (u32x4){0u, 0u, 0u, 0u}; }
    const bool prep = wave >= 1 && wave <= 6;
    const int seg = (wave - 1) >> 1, th = (tid - 64) & 127, chunk8 = th & 15, tg = th >> 4;
    const int chan = (seg == 0 ? hk * 128 : seg == 1 ? 2048 + hk * 128 : 4096 + hv * 128) + chunk8 * 8;
    if (prep && tg == 0) {
#pragma unroll
        for (int j = 0; j < 4; ++j) { *(LAS f32x4*)(lds + R_CW + ((seg * 16 + chunk8) * 4 + j) * 32) = *(const f32x4*)(cw + (size_t)j * QKVD + chan);
                                      *(LAS f32x4*)(lds + R_CW + ((seg * 16 + chunk8) * 4 + j) * 32 + 16) = *(const f32x4*)(cw + (size_t)j * QKVD + chan + 4); }
    }
    const f32x4 nwa = *(const f32x4*)(nw + 8 * (lane & 15)), nwb = *(const f32x4*)(nw + 8 * (lane & 15) + 4);
    const __amdgpu_buffer_rsrc_t rs_proj = __builtin_amdgcn_make_buffer_rsrc((void*)(PROJ - 3 * PROJW), 0, (int)((size_t)(MPAD + 3) * PROJW * 2), 0x00020000);
    const __amdgpu_buffer_rsrc_t rs_og = __builtin_amdgcn_make_buffer_rsrc((void*)OG, 0, (int)((size_t)MPAD * VALD * 2), 0x00020000);
    const int vo_pre = ((tg * 4) * PROJW + chan) * 2;
    const int vo_z = ((3 + (lane >> 4)) * PROJW + 8192 + hv * 128 + 8 * (lane & 15)) * 2, vo_og = ((lane >> 4) * VALD + hv * 128 + 8 * (lane & 15)) * 2;
    u32x4 pre[7]; float lg_b = 0.f, lg_a = 0.f; u32x4 zpre = (u32x4){0u, 0u, 0u, 0u};
    const int nch = (T + 31) >> 5;
#define REC_PREFETCH(ch) do { const int t0_ = (ch) * 32; const int so_ = (int)((row0 + t0_) * (size_t)(PROJW * 2)); \
        if (prep) { _Pragma("unroll") for (int i = 0; i < 7; ++i) pre[i] = __builtin_amdgcn_raw_buffer_load_b128(rs_proj, vo_pre, so_ + i * (PROJW * 2), 0); } \
        if (wave == 7 && lane < 32) { lg_b = LOGIT[(row0 + t0_ + lane) * 64 + hv]; lg_a = LOGIT[(row0 + t0_ + lane) * 64 + 32 + hv]; } } while (0)
    REC_PREFETCH(0);
    WJob jbB; jbB.ok = false; float wt[64];
#define SIDE_LOAD(jb) do { const __amdgpu_buffer_rsrc_t rs_w = __builtin_amdgcn_make_buffer_rsrc((void*)(jb).W, 0, 0x7ffffff0, 0x00020000); \
        const int vo_w = ((jb).n0 + lane) * 4, ld_w = (jb).N * 4, so_w = (jb).k0 * ld_w; \
        _Pragma("unroll") for (int i = 0; i < 64; ++i) wt[i] = __uint_as_float(__builtin_amdgcn_raw_buffer_load_b32(rs_w, vo_w, so_w + i * ld_w, 0)); } while (0)
#define SIDE_STORE(jb) do { bf16_t* dst = (jb).WT + (size_t)wjob_row((jb).n0 + lane, (jb).mode) * (jb).Kd + (jb).k0; \
        _Pragma("unroll") for (int c = 0; c < 8; ++c) { u32x4 o; o.x = pk2(wt[8 * c], wt[8 * c + 1]); o.y = pk2(wt[8 * c + 2], wt[8 * c + 3]); o.z = pk2(wt[8 * c + 4], wt[8 * c + 5]); o.w = pk2(wt[8 * c + 6], wt[8 * c + 7]); \
            *(u32x4*)(dst + 8 * c) = o; } } while (0)
#define SIDE_KILL() do { _Pragma("unroll") for (int i = 0; i < 64; ++i) asm volatile("" : "=v"(wt[i])); } while (0)
    for (int n = -1; n < nch; ++n) {
        const int t0 = n * 32;
        LAS unsigned char* setc = lds + (n & 1) * R_SET;
        LAS float* GC = (LAS float*)(lds + R_G + (n & 1) * 1024); LAS float* BETA = GC + 32; LAS float* EGC = GC + 64; LAS float* BE1 = GC + 96; LAS float* EGL = GC + 128; LAS float* GLp = GC + 160;
        R_OPAQUE();
        if (wave == 7) { if (jbB.ok) SIDE_STORE(jbB); jbB.ok = false; }
        if (n >= 0) {
            if (wave < 6) {
                const int arow0 = (wave == 1 || wave == 5) ? 16 : 0, brow0 = (wave == 0 || wave == 3) ? 0 : 16;
                const LAS unsigned char* Ab = setc + R_KR + (arow0 + fr) * 272 + fq * 16;
                const LAS unsigned char* Bb = setc + (wave < 3 ? R_KR : R_QR) + (brow0 + fr) * 272 + fq * 16;
                f32x4 d = (f32x4){0.f, 0.f, 0.f, 0.f};
#pragma unroll
                for (int ks = 0; ks < 4; ++ks) d = mfma16(*(const LAS bf16x8*)(Ab + ks * 64), *(const LAS bf16x8*)(Bb + ks * 64), d);
                const int c = brow0 + fr, s0 = arow0 + 4 * fq;
                const float gcc = GC[c]; const f32x4 gcs = *(const LAS f32x4*)(GC + s0);
                const float bc = (wave < 3) ? BETA[c] : 1.f;
                f32x4 v;
#pragma unroll
                for (int r = 0; r < 4; ++r) { const int s = s0 + r; const bool ok = (wave < 3) ? (c > s) : (s <= c); v[r] = ok ? d[r] * bc * __expf(gcc - gcs[r]) : 0.f; }
                if (wave < 2) *(LAS f32x4*)(lds + R_LD + (wave * 256 + fr * 16 + 4 * fq) * 4) = v;
                else if (wave == 2) *(LAS u32x2*)(lds + R_L10 + fr * 48 + (4 * fq) * 2) = pack4(v);
                else *(LAS u32x2*)(lds + R_AM + c * 80 + s0 * 2) = pack4(v);
            }
        }
        __syncthreads();
        R_OPAQUE();
        if (wave == 0) {
            SIDE_KILL();
            if (n >= 0) {
            if (fq < 2) {
                const int blk = fq, c = fr;
                const LAS float* L = (const LAS float*)(lds + R_LD) + blk * 256;
                float Tr[16];
#pragma unroll
                for (int j = 0; j < 16; ++j) Tr[j] = (j == c) ? 1.f : 0.f;
#pragma unroll
                for (int j = 15; j >= 1; --j) {
                    const float tj = Tr[j];
#pragma unroll
                    for (int s4 = 0; s4 * 4 < j; ++s4) { const f32x4 l4 = *(const LAS f32x4*)(L + j * 16 + 4 * s4);
#pragma unroll
                        for (int e = 0; e < 4; ++e) if (4 * s4 + e < j) Tr[4 * s4 + e] -= tj * l4[e]; }
                    if ((j & 3) == 0) asm volatile("" ::: "memory");
                }
                LAS unsigned char* t1 = lds + R_TM1 + (16 * blk + c) * 80 + (16 * blk) * 2; LAS unsigned char* t2 = lds + R_TM2 + (16 * blk + c) * 80 + (16 * blk) * 2;
#pragma unroll
                for (int s4 = 0; s4 < 4; ++s4) { const f32x4 b1 = *(const LAS f32x4*)(BE1 + 16 * blk + 4 * s4), b2 = *(const LAS f32x4*)(BETA + 16 * blk + 4 * s4);
                    const f32x4 tv = (f32x4){Tr[4 * s4], Tr[4 * s4 + 1], Tr[4 * s4 + 2], Tr[4 * s4 + 3]};
                    *(LAS u32x2*)(t1 + s4 * 8) = pack4(tv * b1); *(LAS u32x2*)(t2 + s4 * 8) = pack4(tv * b2); }
                if (blk == 0) {
#pragma unroll
                    for (int j = 0; j < 16; ++j) *(LAS bf16_t*)(lds + R_TT0 + j * 48 + c * 2) = (bf16_t)f2bf(Tr[j]);
                } else {
#pragma unroll
                    for (int s4 = 0; s4 < 4; ++s4) *(LAS u32x2*)(lds + R_T11 + c * 48 + s4 * 8) = pack4((f32x4){Tr[4 * s4], Tr[4 * s4 + 1], Tr[4 * s4 + 2], Tr[4 * s4 + 3]});
                }
            }
            R_LDSFENCE();
            bf16x8 a = zero8, b = zero8;
            if (fq < 2) { a = *(const LAS bf16x8*)(lds + R_L10 + fr * 48 + fq * 16); b = *(const LAS bf16x8*)(lds + R_TT0 + fr * 48 + fq * 16); }
            f32x4 m1 = mfma16(a, b, (f32x4){0.f, 0.f, 0.f, 0.f});
            *(LAS u32x2*)(lds + R_M1 + fr * 48 + (4 * fq) * 2) = pack4(m1);
            R_LDSFENCE();
            a = zero8; b = zero8;
            if (fq < 2) { a = *(const LAS bf16x8*)(lds + R_T11 + fr * 48 + fq * 16); b = *(const LAS bf16x8*)(lds + R_M1 + fr * 48 + fq * 16); }
            const f32x4 t10 = mfma16(a, b, (f32x4){0.f, 0.f, 0.f, 0.f});
            const float be1 = BE1[fr], be2 = BETA[fr];
#pragma unroll
            for (int r = 0; r < 4; ++r) { *(LAS bf16_t*)(lds + R_TM1 + (16 + 4 * fq + r) * 80 + fr * 2) = (bf16_t)f2bf(-t10[r] * be1);
                                           *(LAS bf16_t*)(lds + R_TM2 + (16 + 4 * fq + r) * 80 + fr * 2) = (bf16_t)f2bf(-t10[r] * be2); }
            }
        } else if (n + 1 < nch) {
            const int t1 = (n + 1) * 32;
            LAS unsigned char* setn = lds + ((n + 1) & 1) * R_SET;
            if (prep) {
                SIDE_KILL();
                const int chunk8 = fr, tg = 4 * ((wave - 1) & 1) + fq;
                float cwr[4][8];
#pragma unroll
                for (int j = 0; j < 4; ++j) { const f32x4 c0 = *(const LAS f32x4*)(lds + R_CW + ((seg * 16 + chunk8) * 4 + j) * 32), c1 = *(const LAS f32x4*)(lds + R_CW + ((seg * 16 + chunk8) * 4 + j) * 32 + 16);
                    cwr[j][0] = c0[0]; cwr[j][1] = c0[1]; cwr[j][2] = c0[2]; cwr[j][3] = c0[3]; cwr[j][4] = c1[0]; cwr[j][5] = c1[1]; cwr[j][6] = c1[2]; cwr[j][7] = c1[3]; }
                float xw[3][8];
#pragma unroll
                for (int i = 0; i < 3; ++i) { const unsigned wv[4] = {pre[i].x, pre[i].y, pre[i].z, pre[i].w};
#pragma unroll
                    for (int e = 0; e < 4; ++e) { xw[i][2 * e] = __uint_as_float(wv[e] << 16); xw[i][2 * e + 1] = __uint_as_float(wv[e] & 0xffff0000u); } }
                if (n + 1 == 0 && tg == 0) {
                    const __amdgpu_buffer_rsrc_t rs_hist = __builtin_amdgcn_make_buffer_rsrc((void*)hist, 0, hist ? 3 * QKVD * 4 : 0, 0x00020000);
                    const int vo_hist = ((seg == 0 ? hk * 128 : seg == 1 ? 2048 + hk * 128 : 4096 + hv * 128) + chunk8 * 8) * 4;
#pragma unroll
                    for (int i = 0; i < 3; ++i)
#pragma unroll
                        for (int e = 0; e < 8; ++e) xw[i][e] = __uint_as_float(__builtin_amdgcn_raw_buffer_load_b32(rs_hist, vo_hist + e * 4, i * (QKVD * 4), 0));
                }
                float y[4][8];
#pragma unroll
                for (int i = 0; i < 4; ++i) {
                    float xn[8]; { const unsigned wv[4] = {pre[i + 3].x, pre[i + 3].y, pre[i + 3].z, pre[i + 3].w};
#pragma unroll
                        for (int e = 0; e < 4; ++e) { xn[2 * e] = __uint_as_float(wv[e] << 16); xn[2 * e + 1] = __uint_as_float(wv[e] & 0xffff0000u); } }
                    float ss = 0.f;
#pragma unroll
                    for (int e = 0; e < 8; ++e) { float a = cwr[0][e] * xw[0][e] + cwr[1][e] * xw[1][e] + cwr[2][e] * xw[2][e] + cwr[3][e] * xn[e];
                        a = silu_f(a); y[i][e] = a; ss += a * a; xw[0][e] = xw[1][e]; xw[1][e] = xw[2][e]; xw[2][e] = xn[e]; }
                    if (seg < 2) { ss = row16_sum(ss);
                        float r = __builtin_amdgcn_rsqf(ss + EPS); if (seg == 0) r *= 0.08838834764831845f;
#pragma unroll
                        for (int e = 0; e < 8; ++e) y[i][e] *= r; }
                }
                if (seg < 2) {
                    LAS unsigned char* dst = setn + (seg == 0 ? R_QR : R_KR) + (tg * 4) * 272 + chunk8 * 16;
#pragma unroll
                    for (int i = 0; i < 4; ++i) { u32x4 w; w.x = pk2(y[i][0], y[i][1]); w.y = pk2(y[i][2], y[i][3]); w.z = pk2(y[i][4], y[i][5]); w.w = pk2(y[i][6], y[i][7]); *(LAS u32x4*)(dst + i * 272) = w; }
                }
                if (seg >= 1) {
                    LAS unsigned char* dst = setn + (seg == 1 ? R_KT : R_VT) + (chunk8 * 8) * 80 + (tg * 4) * 2;
#pragma unroll
                    for (int e = 0; e < 8; ++e) { u32x2 w; w.x = pk2(y[0][e], y[1][e]); w.y = pk2(y[2][e], y[3][e]); *(LAS u32x2*)(dst + e * 80) = w; }
                }
            }
            if (wave == 7) {
                LAS float* GCn = (LAS float*)(lds + R_G + ((n + 1) & 1) * 1024);
                const bool valid = lane < 32 && (t1 + lane) < T;
                const float xs = lg_a + dtb, en = __expf(-fabsf(xs));
                const float l1p = en < 0.01f ? en * (1.f - en * (0.5f - en * (1.f / 3.f))) : __logf(1.f + en);
                const float sp = fmaxf(xs, 0.f) + l1p;
                float gc = valid ? Aneg * sp : 0.f; const float beta = valid ? __builtin_amdgcn_rcpf(1.f + __expf(-lg_b)) : 0.f;
#pragma unroll
                for (int d = 1; d < 32; d <<= 1) { const float o = __shfl_up(gc, d); if (lane >= d) gc += o; }
                const float gl = __shfl(gc, 31);
                const float e = __expf(gc);
                if (lane < 32) { GCn[lane] = gc; GCn[32 + lane] = beta; GCn[64 + lane] = e; GCn[96 + lane] = beta * e; GCn[128 + lane] = __expf(gl - gc); if (lane == 31) GCn[160] = e; }
                jbB = wjob_decode(1, side_item0 + (n + 1) * side_stride); if (jbB.ok) SIDE_LOAD(jbB);
            }
        }
        if (n >= 0) zpre = __builtin_amdgcn_raw_buffer_load_b128(rs_proj, vo_z, (int)((row0 + t0 + wave * 4) * (size_t)(PROJW * 2)), 0);
        if (n + 2 < nch) REC_PREFETCH(n + 2);
        __syncthreads();
        if (n < 0) continue;
        R_OPAQUE();
        f32x4 u[2];
        {
            const bf16x8 aK = *(const LAS bf16x8*)(setc + R_KT + (16 * wave + fr) * 80 + fq * 16);
            const bf16x8 bV = *(const LAS bf16x8*)(setc + R_VT + (16 * wave + fr) * 80 + fq * 16);
#pragma unroll
            for (int t = 0; t < 2; ++t) {
                const f32x4 wt = mfma16(aK, *(const LAS bf16x8*)(lds + R_TM1 + (16 * t + fr) * 80 + fq * 16), (f32x4){0.f, 0.f, 0.f, 0.f});
                *(LAS u32x2*)(lds + R_WR + (16 * t + fr) * 272 + (16 * wave + 4 * fq) * 2) = pack4(wt);
                u[t] = mfma16(*(const LAS bf16x8*)(lds + R_TM2 + (16 * t + fr) * 80 + fq * 16), bV, (f32x4){0.f, 0.f, 0.f, 0.f});
            }
        }
        __syncthreads();
        R_OPAQUE();
        f32x4 acc1[2], acc2[2];
        acc1[0] = acc1[1] = acc2[0] = acc2[1] = (f32x4){0.f, 0.f, 0.f, 0.f};
#pragma unroll
        for (int ks = 0; ks < 4; ++ks) {
            const bf16x8 bS = *(const LAS bf16x8*)(lds + R_ST + (16 * wave + fr) * 272 + ks * 64 + fq * 16);
#pragma unroll
            for (int t = 0; t < 2; ++t) {
                acc1[t] = mfma16(*(const LAS bf16x8*)(lds + R_WR + (16 * t + fr) * 272 + ks * 64 + fq * 16), bS, acc1[t]);
                acc2[t] = mfma16(*(const LAS bf16x8*)(setc + R_QR + (16 * t + fr) * 272 + ks * 64 + fq * 16), bS, acc2[t]);
            }
        }
#pragma unroll
        for (int t = 0; t < 2; ++t) {
            const f32x4 egl4 = *(const LAS f32x4*)(EGL + 16 * t + 4 * fq), egc4 = *(const LAS f32x4*)(EGC + 16 * t + 4 * fq);
            const f32x4 vn = u[t] - acc1[t];
            *(LAS u32x2*)(lds + R_VN + (16 * wave + fr) * 80 + (16 * t + 4 * fq) * 2) = pack4(vn);
            *(LAS u32x2*)(lds + R_VN2 + (16 * wave + fr) * 80 + (16 * t + 4 * fq) * 2) = pack4(vn * egl4);
            acc2[t] = acc2[t] * egc4;
        }
        R_LDSFENCE();
        {
            const bf16x8 bVN = *(const LAS bf16x8*)(lds + R_VN + (16 * wave + fr) * 80 + fq * 16);
            const bf16x8 bVN2 = *(const LAS bf16x8*)(lds + R_VN2 + (16 * wave + fr) * 80 + fq * 16);
#pragma unroll
            for (int t = 0; t < 2; ++t) acc2[t] = mfma16(*(const LAS bf16x8*)(lds + R_AM + (16 * t + fr) * 80 + fq * 16), bVN, acc2[t]);
            const float gl = __uint_as_float(__builtin_amdgcn_readfirstlane(__float_as_uint(GLp[0])));
#pragma unroll
            for (int i = 0; i < 8; ++i) Sacc[i] = mfma16(*(const LAS bf16x8*)(setc + R_KT + (16 * i + fr) * 80 + fq * 16), bVN2, Sacc[i] * gl);
        }
#pragma unroll
        for (int i = 0; i < 8; ++i) *(LAS u32x2*)(lds + R_ST + (16 * wave + fr) * 272 + (16 * i + 4 * fq) * 2) = pack4(Sacc[i]);
#pragma unroll
        for (int t = 0; t < 2; ++t)
#pragma unroll
            for (int r = 0; r < 4; ++r) *(LAS float*)(setc + R_OB + ((16 * t + 4 * fq + r) * 132 + 16 * wave + fr) * 4) = acc2[t][r];
        __syncthreads();
        {
            const int tok = fq, sg = fr, tt = wave * 4 + tok;
            const f32x4 o0 = *(const LAS f32x4*)(setc + R_OB + (tt * 132 + 8 * sg) * 4), o1 = *(const LAS f32x4*)(setc + R_OB + (tt * 132 + 8 * sg + 4) * 4);
            float ss = (o0[0] * o0[0] + o0[1] * o0[1]) + (o0[2] * o0[2] + o0[3] * o0[3]) + (o1[0] * o1[0] + o1[1] * o1[1]) + (o1[2] * o1[2] + o1[3] * o1[3]);
            ss = row16_sum(ss);
            const float r = __builtin_amdgcn_rsqf(ss * (1.f / 128.f) + EPS);
            const unsigned zw[4] = {zpre.x, zpre.y, zpre.z, zpre.w};
            float g[8];
#pragma unroll
            for (int e = 0; e < 4; ++e) { const float z0 = __uint_as_float(zw[e] << 16), z1 = __uint_as_float(zw[e] & 0xffff0000u); g[2 * e] = silu_f(z0); g[2 * e + 1] = silu_f(z1); }
            u32x4 w;
            w.x = pk2(o0[0] * r * nwa[0] * g[0], o0[1] * r * nwa[1] * g[1]); w.y = pk2(o0[2] * r * nwa[2] * g[2], o0[3] * r * nwa[3] * g[3]);
            w.z = pk2(o1[0] * r * nwb[0] * g[4], o1[1] * r * nwb[1] * g[5]); w.w = pk2(o1[2] * r * nwb[2] * g[6], o1[3] * r * nwb[3] * g[7]);
            if (t0 + tt < T) __builtin_amdgcn_raw_buffer_store_b128(w, rs_og, vo_og, (int)((row0 + t0 + wave * 4) * (size_t)(VALD * 2)), 0);
        }
    }
    R_OPAQUE();
    const int vo_so = ((4 * fq) * 128 + 16 * wave + fr) * 4;
#undef REC_PREFETCH
#undef R_OPAQUE
#undef SIDE_LOAD
#undef SIDE_STORE
#undef SIDE_KILL
#pragma unroll
    for (int i = 0; i < 8; ++i)
#pragma unroll
        for (int r = 0; r < 4; ++r) __builtin_amdgcn_raw_buffer_store_b32(__float_as_uint(Sacc[i][r]), rs_so, vo_so, (16 * i + r) * 512, 0);
    __syncthreads();
}

struct Args { const float* in[18]; float* out; unsigned char* ws; int lo, hi; };
constexpr int NSTEPS = 64;
constexpr int SLICE_KT_GU = 8;
constexpr int SLICE_KT = 4, NSL_OUT = VALD / 64 / SLICE_KT, NSL_DN = FF / 64 / SLICE_KT, NSL_PL = 512 / 64 / SLICE_KT;
#ifndef PROBE
#define PROBE 0
#endif
#define REP(k) _Pragma("unroll") for (int rep_ = 0; rep_ < ((PROBE) == (k) ? 2 : 1); ++rep_)

__global__ void __launch_bounds__(512, 2) mega(Args a) {
    extern __shared__ __attribute__((aligned(16))) unsigned char lds_raw[];
    LAS unsigned char* lds = (LAS unsigned char*)lds_raw;
    volatile LAS unsigned* MISC = (volatile LAS unsigned*)(lds + MISC_OFF);
    const int G = gridDim.x, bx = blockIdx.x, vcu = (G % 8 == 0) ? (bx % 8) * (G / 8) + bx / 8 : bx;
    const int ngw = G * 8;
    const int lo = a.lo, hi = a.hi;
    unsigned* ctl = (unsigned*)(a.ws + WS_CTL);
    const int wave_k = __builtin_amdgcn_readfirstlane((int)threadIdx.x >> 6);
    if (threadIdx.x < 64) MISC[threadIdx.x] = 0u;
    __syncthreads();
    XcdBarrier bar; bar.bar = ctl + CW_BAR; bar.x = 0; bar.st = MISC + 8;
    if (hi - lo > 1) bar = xcd_barrier_post(ctl + CW_BAR, MISC + 8);

#define LOAD_PTRS \
    const float* x_prompt = KARG(const float*, 0); const float* x_sample = KARG(const float*, 8); const float* st_conv = KARG(const float*, 16); const float* st_S = KARG(const float*, 24); \
    const float* st_pool = KARG(const float*, 32); const float* norm_mix_w = KARG(const float*, 40); const float* norm_ffn_w = KARG(const float*, 48); const float* final_norm_w = KARG(const float*, 56); \
    const float* w_in = KARG(const float*, 64); const float* conv_w = KARG(const float*, 72); const float* A_log = KARG(const float*, 80); const float* dt_bias = KARG(const float*, 88); \
    const float* gnorm_w = KARG(const float*, 96); const float* w_out = KARG(const float*, 104); const float* pool_w = KARG(const float*, 112); const float* pool_scale = KARG(const float*, 120); \
    const float* w_gu = KARG(const float*, 128); const float* w_down = KARG(const float*, 136); float* out = KARG(float*, 144); unsigned char* ws = KARG(unsigned char*, 152); \
    bf16_t* WIN = (bf16_t*)(ws + WS_WIN); bf16_t* WOUT = (bf16_t*)(ws + WS_WOUT); bf16_t* WGU = (bf16_t*)(ws + WS_WGU); bf16_t* WDN = (bf16_t*)(ws + WS_WDN); bf16_t* WPL = (bf16_t*)(ws + WS_WPL); \
    f16_t* X = (f16_t*)(ws + WS_X); bf16_t* H = (bf16_t*)(ws + WS_H); bf16_t* PROJ = (bf16_t*)(ws + WS_PROJ); bf16_t* ACT = PROJ; float* LOGIT = (float*)(ws + WS_LOGIT); \
    bf16_t* OG = (bf16_t*)(ws + WS_OG); bf16_t* DP = OG; float* PART = (float*)(ws + WS_PART); \
    (void)x_prompt; (void)x_sample; (void)st_conv; (void)st_S; (void)st_pool; (void)norm_mix_w; (void)norm_ffn_w; (void)final_norm_w; (void)w_in; (void)conv_w; (void)A_log; (void)dt_bias; (void)gnorm_w; \
    (void)w_out; (void)pool_w; (void)pool_scale; (void)w_gu; (void)w_down; (void)out; (void)WIN; (void)WOUT; (void)WGU; (void)WDN; (void)WPL; (void)X; (void)H; (void)PROJ; (void)ACT; (void)LOGIT; (void)OG; (void)DP; (void)PART;

    int step = 0;
#define STEP_BEGIN if (step >= lo && step < hi) { int tid; asm volatile("v_mbcnt_lo_u32_b32 %0, -1, 0\n\tv_mbcnt_hi_u32_b32 %0, -1, %0" : "=v"(tid)); tid += wave_k * 64; asm volatile("" : "+v"(tid)); const int lane = tid & 63, wave = __builtin_amdgcn_readfirstlane(tid >> 6), gw = vcu * 8 + wave; int bxo = bx; asm volatile("" : "+s"(bxo)); int ngwo = ngw; asm volatile("" : "+s"(ngwo)); (void)lane; (void)gw; (void)bxo; (void)ngwo; LOAD_PTRS
#define STEP_END   if (step + 1 < hi) xcd_barrier(bar, tid); } ++step;

    STEP_BEGIN
    REP(5) {
        LAS float* scr = (LAS float*)(lds + wave * 16640);
        for (int it = gw; it < WL_P0; it += ngw) { const WJob jb = wjob_decode(0, it); transpose_item(jb.W, jb.N, jb.WT, jb.Kd, jb.k0, jb.n0, jb.mode, scr, lane); }
        for (int it = (G == 256 ? 2 * SIDE_SLOTS * 256 : 0) + gw; it < WL_SEQ; it += ngw) { const WJob jb = wjob_decode(1, it); transpose_item(jb.W, jb.N, jb.WT, jb.Kd, jb.k0, jb.n0, jb.mode, scr, lane); }
        const size_t gt = (size_t)vcu * 512 + tid, ngt = (size_t)G * 512;
        for (size_t i = gt; i < (size_t)2 * (NIN_PAD - IND) * D / 8; i += ngt) { const size_t j = i / ((size_t)(NIN_PAD - IND) * D / 8), r = i % ((size_t)(NIN_PAD - IND) * D / 8);
            ((u32x4*)(WIN + (size_t)j * NIN_PAD * D + (size_t)IND * D))[r] = (u32x4){0u, 0u, 0u, 0u}; }
        for (size_t i = gt; i < (size_t)(MPAD - MT) * VALD / 8; i += ngt) ((u32x4*)(OG + (size_t)MT * VALD))[i] = (u32x4){0u, 0u, 0u, 0u};
        if (rep_ == 0) norm_phase<3>(X, norm_mix_w, H, const_cast<float*>(x_prompt), const_cast<float*>(x_sample), gw, ngwo, lane, PART, 0);
    }
    STEP_END

    for (int layer = 0; layer < 4; ++layer) {
        const int j = layer >> 1;
        if (layer > 0) {
        STEP_BEGIN
        REP(4) { const int nsl_ = (layer > 0 && rep_ == 0) ? NSL_DN : 0;
          if (layer & 1) norm_phase<1>(X, norm_mix_w + (size_t)layer * D, H, out + O_POOL_P + (size_t)j * 8 * 15 * D, out + O_POOL_S + (size_t)j * 8 * 15 * D, gw, ngwo, lane, PART, nsl_);
        else norm_phase<0>(X, norm_mix_w + (size_t)layer * D, H, nullptr, nullptr, gw, ngwo, lane, PART, nsl_); }
        STEP_END
        }
        if ((layer & 1) == 0) {
            STEP_BEGIN
            REP(2) { pg8::Gemm g{H, WIN + (size_t)j * NIN_PAD * D, D, D, NPANEL, NIN_PAD / 256, D, 0, 0}; pg8::StaticOrder S; S.init(NPANEL, NIN_PAD / 256, G, bxo);
              pg8::EpiInProj E{PROJ, LOGIT, out + O_CONV_P + (size_t)j * 8 * 3 * QKVD, out + O_CONV_S + (size_t)j * 8 * 3 * QKVD};
              pg8::gemm_phase<pg8::EpiInProj, pg8::StaticOrder, true, true>(lds, g, S, E, tid);
              if (PROBE == 20) { pg8::EpiNull E0{}; __syncthreads(); pg8::gemm_phase<pg8::EpiNull, pg8::StaticOrder, true, true>(lds, g, S, E0, tid); } }
            STEP_END
            STEP_BEGIN
            REP(1) {
                const float* cw = conv_w + (size_t)j * 4 * QKVD;
                for (int it = bxo; it < 512; it += G) {
                    const int sample = it >= 256, bh = it & 255, b = bh >> 5, hv = bh & 31;
                    const float Aneg = -expf(A_log[j * NVH + hv]), dtb = dt_bias[j * NVH + hv];
                    const size_t so = ((size_t)(j * 8 + b) * NVH + hv) * 128 * 128;
                    rec_stream(lds, PROJ, LOGIT, sample ? (size_t)MP + b * 16 : (size_t)b * 2048, sample ? 16 : 2048, hv,
                               sample ? st_conv + ((size_t)(j * 8 + b) * 3) * QKVD : nullptr, cw, sample ? st_S + so : nullptr, Aneg, dtb, gnorm_w + (size_t)j * 128, OG,
                               out + (sample ? O_S_S : O_S_P) + so, tid, G == 256 ? (j * SIDE_SLOTS + (sample ? 64 : 0)) * G + bxo : -(1 << 30), G);
                }
            }
            STEP_END
            STEP_BEGIN
            { pg8::Gemm g{OG, WOUT + (size_t)j * D * VALD, VALD, VALD, NPANEL, D / 256, VALD, 0, 0}; pg8::SplitOrder S; S.init2(NPANEL - 1, D / 256, G, bxo, VALD / 64, SLICE_KT);
              pg8::EpiResidual E{X, layer == 0 ? x_prompt : nullptr, nullptr, PART};
              pg8::gemm_phase<pg8::EpiResidual, pg8::SplitOrder, true, true>(lds, g, S, E, tid);
              if (PROBE == 7) { pg8::EpiResidual E2{(f16_t*)(ws + WS_PROJ + (size_t)200 * 1024 * 1024), nullptr, nullptr, PART}; __syncthreads(); pg8::gemm_phase<pg8::EpiResidual, pg8::SplitOrder, true, true>(lds, g, S, E2, tid); } }
            STEP_END
        } else {
            STEP_BEGIN
            REP(8) pool_phase(H, st_pool + (size_t)j * 8 * 15 * D, DP, vcu, G, tid);
            STEP_END
            STEP_BEGIN
            { pg8::Gemm g{DP, WPL + (size_t)j * D * 512, D, 512, NPANEL, D / 256, 512, 1, 512}; pg8::SplitOrder S; S.init2(NPANEL - 1, D / 256, G, bxo, 512 / 64, SLICE_KT);
              pg8::EpiResidual E{X, nullptr, pool_scale + (size_t)j * D, PART};
              pg8::gemm_phase<pg8::EpiResidual, pg8::SplitOrder, true, true>(lds, g, S, E, tid);
              if (PROBE == 9) { pg8::EpiResidual E2{(f16_t*)(ws + WS_PROJ + (size_t)200 * 1024 * 1024), nullptr, pool_scale + (size_t)j * D, PART}; __syncthreads(); pg8::gemm_phase<pg8::EpiResidual, pg8::SplitOrder, true, true>(lds, g, S, E2, tid); } }
            STEP_END
        }
        STEP_BEGIN
        REP(4) norm_phase<0>(X, norm_ffn_w + (size_t)layer * D, H, nullptr, nullptr, gw, ngwo, lane, PART, rep_ != 0 ? 0 : ((layer & 1) == 0 ? NSL_OUT : NSL_PL));
        STEP_END
        STEP_BEGIN
        REP(3) { pg8::Gemm g{H, WGU + (size_t)layer * 2 * FF * D, D, D, NPANEL, 2 * FF / 256, D, 0, 0}; pg8::SplitOrder S; S.init2(NPANEL - 1, 2 * FF / 256, G, bxo, D / 64, SLICE_KT_GU, pg8::WGM_WIDE);
          pg8::EpiSwiGLU E{ACT, PART};
          pg8::gemm_phase<pg8::EpiSwiGLU, pg8::SplitOrder, true, true>(lds, g, S, E, tid); }
        STEP_END
        STEP_BEGIN
        swiglu_reduce_phase(PART, D / 64 / SLICE_KT_GU, ACT, gw, ngw, lane);
        STEP_END
        STEP_BEGIN
        { pg8::Gemm g{ACT, WDN + (size_t)layer * D * FFP, FFP, FFP, NPANEL, D / 256, FF, 0, 0}; pg8::SplitOrder S; S.init2(NPANEL - 1, D / 256, G, bxo, FF / 64, SLICE_KT);
          pg8::EpiResidual E{X, nullptr, nullptr, PART};
          pg8::gemm_phase<pg8::EpiResidual, pg8::SplitOrder, true, true>(lds, g, S, E, tid);
          if (PROBE == 6) { pg8::EpiResidual E2{(f16_t*)(ws + WS_PROJ + (size_t)200 * 1024 * 1024), nullptr, nullptr, PART}; __syncthreads(); pg8::gemm_phase<pg8::EpiResidual, pg8::SplitOrder, true, true>(lds, g, S, E2, tid); } }
        STEP_END
    }
    STEP_BEGIN
    REP(4) norm_phase<2>(X, final_norm_w, nullptr, out, nullptr, gw, ngwo, lane, PART, rep_ == 0 ? NSL_DN : 0);
    STEP_END
#undef STEP_BEGIN
#undef STEP_END
}

#ifndef MK_ONE_LAUNCH
#define MK_ONE_LAUNCH 1
#endif
extern "C" void kernel_launch(void* const* d_in, const int* in_sizes, int n_in, void* d_out, int out_size, void* d_ws, size_t ws_size, hipStream_t stream) {
    static int grid = 0;
    if (grid == 0) {
        if (n_in != 18 || ws_size < WS_END) { fprintf(stderr, "kernel_launch: expected 18 inputs and >= %zu bytes of workspace (got %d, %zu)\n", (size_t)WS_END, n_in, ws_size); grid = -1; return; }
        int dev = 0, cus = 0, per_cu = 0;
        if (hipGetDevice(&dev) != hipSuccess || hipDeviceGetAttribute(&cus, hipDeviceAttributeMultiprocessorCount, dev) != hipSuccess) { grid = -1; return; }
        if (hipFuncSetAttribute((const void*)mega, hipFuncAttributeMaxDynamicSharedMemorySize, LDS_BYTES) != hipSuccess) { fprintf(stderr, "kernel_launch: hipFuncSetAttribute failed\n"); grid = -1; return; }
        if (hipOccupancyMaxActiveBlocksPerMultiprocessor(&per_cu, (const void*)mega, 512, LDS_BYTES) != hipSuccess || per_cu < 1) fprintf(stderr, "kernel_launch: occupancy query reports %d\n", per_cu);
        (void)hipGetLastError();
        grid = cus;
    }
    if (grid < 0) return;
    hipMemsetAsync((char*)d_ws + WS_CTL, 0, CTL_BYTES, stream);
    Args a{};
    for (int i = 0; i < 18; ++i) a.in[i] = (const float*)d_in[i];
    a.out = (float*)d_out; a.ws = (unsigned char*)d_ws;
#if MK_ONE_LAUNCH
    a.lo = 0; a.hi = NSTEPS;
    hipLaunchKernelGGL(mega, dim3(grid), dim3(512), LDS_BYTES, stream, a);
#else
    for (int s = 0; s < NSTEPS; ++s) { a.lo = s; a.hi = s + 1; hipLaunchKernelGGL(mega, dim3(grid), dim3(512), LDS_BYTES, stream, a); }
#endif
}
```

```cpp
#include <hip/hip_runtime.h>
#include <cstdio>
#include <cstdint>

#define LAS __attribute__((address_space(3)))
typedef unsigned short bf16_t;
typedef short bf16x8 __attribute__((ext_vector_type(8)));
typedef float f32x4 __attribute__((ext_vector_type(4)));
typedef float f32x2 __attribute__((ext_vector_type(2)));
typedef unsigned u32x4 __attribute__((ext_vector_type(4)));
typedef unsigned u32x2 __attribute__((ext_vector_type(2)));
typedef _Float16 f16_t;
typedef _Float16 f16x4 __attribute__((ext_vector_type(4)));
typedef _Float16 f16x8 __attribute__((ext_vector_type(8)));

constexpr int D = 2048, QKVD = 8192, VALD = 4096, IND = 12352, FF = 5632, NVH = 32;
constexpr int FFP = FF + 64;
constexpr int MP = 16384, MS = 128, MT = MP + MS, MPAD = 16640, NPANEL = MPAD / 256;
constexpr int NIN_PAD = 12544, PROJW = 12352;
constexpr float EPS = 1e-6f;
constexpr size_t O_CONV_P = (size_t)MT * D, O_S_P = O_CONV_P + 2 * 8 * 3 * QKVD, O_POOL_P = O_S_P + (size_t)2 * 8 * 32 * 128 * 128, O_CONV_S = O_POOL_P + 2 * 8 * 15 * D,
                 O_S_S = O_CONV_S + 2 * 8 * 3 * QKVD, O_POOL_S = O_S_S + (size_t)2 * 8 * 32 * 128 * 128;
constexpr size_t WS_CTL = 0, CTL_BYTES = 65536;
constexpr size_t WS_WIN = 1u << 20;
constexpr size_t WS_WOUT = WS_WIN + (size_t)2 * NIN_PAD * D * 2;
constexpr size_t WS_WGU = WS_WOUT + (size_t)2 * D * VALD * 2;
constexpr size_t WS_WDN = WS_WGU + (size_t)4 * 2 * FF * D * 2;
constexpr size_t WS_WPL = WS_WDN + (size_t)4 * D * FFP * 2;
constexpr size_t WS_X = WS_WPL + (size_t)2 * D * 512 * 2;
constexpr size_t WS_H = WS_X + (size_t)MPAD * D * 4;
constexpr size_t WS_PROJ = WS_H + (size_t)MPAD * D * 2;
constexpr size_t WS_LOGIT = WS_PROJ + (size_t)MPAD * PROJW * 2;
constexpr size_t WS_OG = WS_LOGIT + (size_t)MPAD * 64 * 4;
constexpr size_t WS_PART = WS_OG + (size_t)MPAD * VALD * 2;
constexpr size_t WS_END = WS_PART + (size_t)22 * 128 * D * 4;
constexpr int CW_BAR = 4096;
constexpr int RING_BYTES = 131072, LDS_BYTES = 163840, MISC_OFF = LDS_BYTES - 512;

__device__ __forceinline__ float bf2f(bf16_t b) { return __uint_as_float(((unsigned)b) << 16); }
typedef __bf16 bf16x2_t __attribute__((ext_vector_type(2)));
__device__ __forceinline__ unsigned pk2(float lo, float hi) { const f32x2 v = {lo, hi}; return __builtin_bit_cast(unsigned, __builtin_convertvector(v, bf16x2_t)); }
__device__ __forceinline__ unsigned f2bf(float f) { return pk2(f, 0.f); }
template <int CTRL> __device__ __forceinline__ float dpp_mov(float v) { return __int_as_float(__builtin_amdgcn_update_dpp(0, __float_as_int(v), CTRL, 0xf, 0xf, true)); }
__device__ __forceinline__ float row16_sum(float v) { v += dpp_mov<0xB1>(v); v += dpp_mov<0x4E>(v); v += dpp_mov<0x141>(v); v += dpp_mov<0x140>(v); return v; }
__device__ __forceinline__ float wave_sum(float v) {
    v = row16_sum(v);
    const int i = __float_as_int(v);
    return (__int_as_float(__builtin_amdgcn_readlane(i, 0)) + __int_as_float(__builtin_amdgcn_readlane(i, 16))) + (__int_as_float(__builtin_amdgcn_readlane(i, 32)) + __int_as_float(__builtin_amdgcn_readlane(i, 48)));
}
__device__ __forceinline__ float silu_f(float x) { return x * __builtin_amdgcn_rcpf(1.f + __expf(-x)); }

namespace pg8 {
#define PG8_LAS __attribute__((address_space(3)))
constexpr int BM = 256, BK = 64, HALF = 128, HTB = HALF * BK * 2  , STAGE_BYTES = 8 * HTB, NXCD = 8;

__host__ __device__ __forceinline__ int lds_byte(int r, int c) { const int st = (r >> 4) * 2 + (c >> 5), rr = r & 15, cc = c & 31, ob = rr * 64 + cc * 2; return st * 1024 + (ob ^ (((ob >> 9) & 1) << 5)); }
__host__ __device__ __forceinline__ void stage_rc(int b, int& R, int& C) { const int st = b / 1024, sb = b % 1024, swz = sb ^ (((sb >> 9) & 1) << 5); R = (st >> 1) * 16 + swz / 64; C = (st & 1) * 32 + (swz % 64) / 2; }
__host__ __device__ __forceinline__ int perm32(int rho) { const int n = rho >> 4, i = rho & 15; return 8 * (i >> 2) + 4 * n + (i & 3); }

#ifndef WGM_WIDE_V
#define WGM_WIDE_V 8
#endif
#ifndef WGM_NARROW_V
#define WGM_NARROW_V 4
#endif
constexpr int WGM_WIDE = WGM_WIDE_V, WGM_NARROW = WGM_NARROW_V;
struct Unit { int pm, pn, kt0, nkt, slice; };
struct Gemm { const bf16_t* A; const bf16_t* Bt; int lda, ldb, nM, nN, K, grp_shift, grp_k;
    __device__ __forceinline__ size_t aofs(int pn) const { return (size_t)((pn >> grp_shift) * grp_k) * 2; } };

struct StaticOrder {
    int nM, nN, nwg, G, c, WGM;
    __host__ __device__ void init(int nM_, int nN_, int G_, int c_, int wgm_ = WGM_WIDE) { nM = nM_; nN = nN_; nwg = nM * nN; G = G_; c = c_; WGM = wgm_; }
    __host__ __device__ __forceinline__ bool next(int i, Unit& u) const {
        u.pm = 0; u.pn = 0; u.kt0 = 0; u.nkt = 0; u.slice = -1;
        const long L = (long)i * G + c; if (L >= nwg) return false;
        int wgid = (int)L; { const int q = nwg / NXCD, r = nwg % NXCD, xcd = wgid % NXCD, off = wgid / NXCD; wgid = (xcd < r ? xcd * (q + 1) : r * (q + 1) + (xcd - r) * q) + off; }
        const int nig = WGM * nN, gid = wgid / nig, fm = gid * WGM, gsz = (nM - fm) < WGM ? (nM - fm) : WGM;
        u.pm = fm + ((wgid % nig) % gsz); u.pn = (wgid % nig) / gsz; u.kt0 = 0; u.nkt = 0; u.slice = -1; return true;
    }
    __device__ __forceinline__ void a_ready(const Unit&) const {}
    __device__ __forceinline__ void done(const Unit&) const {}
};

struct SplitOrder : StaticOrder {
    int nsl, slice_kt;
    __host__ __device__ __forceinline__ void init2(int nM_full, int nN_, int G_, int c_, int nkt_total, int slice_kt_, int wgm_ = WGM_NARROW) { init(nM_full, nN_, G_, c_, wgm_); slice_kt = slice_kt_; nsl = nkt_total / slice_kt_; }
    __host__ __device__ __forceinline__ bool next(int i, Unit& u) const {
        Unit t; t.pm = 0; t.pn = 0; t.kt0 = 0; t.nkt = 0; t.slice = -1;
        bool ok = StaticOrder::next(i, t);
        if (!ok) {
            const int s = (i - nwg / G) * G + c - (nwg % G);
            if (i >= nwg / G && s >= 0 && s < nN * nsl) { t.pm = nM; t.pn = s % nN; t.slice = s / nN; t.kt0 = t.slice * slice_kt; t.nkt = slice_kt; ok = true; }
        }
        u = t; return ok;
    }
};

__device__ __forceinline__ unsigned cvt_pk_bf16(float lo, float hi) { unsigned r; asm volatile("v_cvt_pk_bf16_f32 %0, %1, %2" : "=v"(r) : "v"(lo), "v"(hi)); return r; }

struct EpiResidual {
    static constexpr bool PERM = true, AFTER_DRAIN = false;
    f16_t* X; const float* Xin32; const float* scale; float* part;
    __device__ __forceinline__ void operator()(const f32x4 (&acc)[2][2][4][2], const Unit& u, int wr, int wc, int fr, int fq) const {
        const int row0 = u.pm * BM + wr * 64 + fr, col0 = u.pn * BM + wc * 32 + 8 * fq;
        f32x4 sv[2][2];
#pragma unroll
        for (int bj = 0; bj < 2; ++bj)
#pragma unroll
            for (int n = 0; n < 2; ++n) sv[bj][n] = scale ? *(const f32x4*)(scale + col0 + bj * HALF + n * 4) : (f32x4){1.f, 1.f, 1.f, 1.f};
        if (u.slice >= 0) {
#pragma unroll
            for (int m = 0; m < 4; ++m) { float* rowp = part + ((size_t)u.slice * 128 + wr * 64 + m * 16 + fr) * D + col0;
#pragma unroll
                for (int bj = 0; bj < 2; ++bj)
#pragma unroll
                    for (int n = 0; n < 2; ++n) *(f32x4*)(rowp + bj * HALF + n * 4) = acc[0][bj][m][n] * sv[bj][n]; }
            return;
        }
#pragma unroll
        for (int ai = 0; ai < 2; ++ai) {
            f32x4 xv[4][2][2];
            if (Xin32) {
#pragma unroll
                for (int m = 0; m < 4; ++m) { const float* rowp = Xin32 + (size_t)(row0 + ai * HALF + m * 16) * D + col0;
#pragma unroll
                    for (int bj = 0; bj < 2; ++bj)
#pragma unroll
                        for (int n = 0; n < 2; ++n) xv[m][bj][n] = *(const f32x4*)(rowp + bj * HALF + n * 4); }
            } else {
                f16x8 hv[4][2];
#pragma unroll
                for (int m = 0; m < 4; ++m) { const f16_t* rowp = X + (size_t)(row0 + ai * HALF + m * 16) * D + col0;
#pragma unroll
                    for (int bj = 0; bj < 2; ++bj) hv[m][bj] = *(const f16x8*)(rowp + bj * HALF); }
#pragma unroll
                for (int m = 0; m < 4; ++m)
#pragma unroll
                    for (int bj = 0; bj < 2; ++bj) { const f16x8 h = hv[m][bj];
                        xv[m][bj][0] = (f32x4){(float)h[0], (float)h[1], (float)h[2], (float)h[3]}; xv[m][bj][1] = (f32x4){(float)h[4], (float)h[5], (float)h[6], (float)h[7]}; }
            }
#pragma unroll
            for (int m = 0; m < 4; ++m) { f16_t* rowp = X + (size_t)(row0 + ai * HALF + m * 16) * D + col0;
#pragma unroll
                for (int bj = 0; bj < 2; ++bj) { const f16x4 a = __builtin_convertvector(xv[m][bj][0] + acc[ai][bj][m][0] * sv[bj][0], f16x4), b = __builtin_convertvector(xv[m][bj][1] + acc[ai][bj][m][1] * sv[bj][1], f16x4);
                    *(f16x8*)(rowp + bj * HALF) = (f16x8){a[0], a[1], a[2], a[3], b[0], b[1], b[2], b[3]}; } }
            asm volatile("" ::: "memory");
        }
    }
};
struct EpiNull {
    static constexpr bool PERM = true, AFTER_DRAIN = false;
    __device__ __forceinline__ void operator()(const f32x4 (&acc)[2][2][4][2], const Unit& u, int wr, int wc, int fr, int fq) const {
#pragma unroll
        for (int ai = 0; ai < 2; ++ai)
#pragma unroll
            for (int m = 0; m < 4; ++m)
#pragma unroll
                for (int bj = 0; bj < 2; ++bj) { asm volatile("" :: "v"(acc[ai][bj][m][0]), "v"(acc[ai][bj][m][1])); }
    }
};
struct EpiInProj {
    static constexpr bool PERM = true, AFTER_DRAIN = false;
    bf16_t* PROJ; float* LOGIT; float* conv_p; float* conv_s;
    __device__ __forceinline__ void operator()(const f32x4 (&acc)[2][2][4][2], const Unit& u, int wr, int wc, int fr, int fq) const {
        const int row0 = u.pm * BM + wr * 64 + fr;
        if (u.pn < 48) {
            const int col0 = u.pn * BM + wc * 32 + 8 * fq;
            const bool tail_unit = u.pn < 32 && ((u.pm & 7) == 7 || u.pm == 64);
#pragma unroll
            for (int ai = 0; ai < 2; ++ai)
#pragma unroll
                for (int m = 0; m < 4; ++m) { const int r = row0 + ai * HALF + m * 16;
                    float* ct = nullptr;
                    if (tail_unit && (u.pm == 64 || (ai == 1 && m == 3))) {
                        if (r < MP) { const int t = r & 2047; if (t >= 2045) ct = conv_p + ((size_t)(r >> 11) * 3 + (t - 2045)) * QKVD; }
                        else if (r < MT) { const int t = r & 15; if (t >= 13) ct = conv_s + ((size_t)((r - MP) >> 4) * 3 + (t - 13)) * QKVD; }
                    }
#pragma unroll
                    for (int bj = 0; bj < 2; ++bj) { const f32x4 v0 = acc[ai][bj][m][0], v1 = acc[ai][bj][m][1];
                        u32x4 w; w.x = cvt_pk_bf16(v0[0], v0[1]); w.y = cvt_pk_bf16(v0[2], v0[3]); w.z = cvt_pk_bf16(v1[0], v1[1]); w.w = cvt_pk_bf16(v1[2], v1[3]);
                        *(u32x4*)(PROJ + (size_t)r * PROJW + col0 + bj * HALF) = w;
                        if (ct) { *(f32x4*)(ct + col0 + bj * HALF) = v0; *(f32x4*)(ct + col0 + bj * HALF + 4) = v1; } } }
        } else if (wc < 2) {
#pragma unroll
            for (int ai = 0; ai < 2; ++ai)
#pragma unroll
                for (int m = 0; m < 4; ++m) { float* lp = LOGIT + (size_t)(row0 + ai * HALF + m * 16) * 64 + wc * 32 + 8 * fq;
                    *(f32x4*)lp = acc[ai][0][m][0]; *(f32x4*)(lp + 4) = acc[ai][0][m][1]; }
        }
    }
};
struct EpiSwiGLU {
    static constexpr bool PERM = true, AFTER_DRAIN = false;
    bf16_t* ACT; float* part;
    __device__ __forceinline__ void operator()(const f32x4 (&acc)[2][2][4][2], const Unit& u, int wr, int wc, int fr, int fq) const {
        const int row0 = u.pm * BM + wr * 64 + fr, j0 = u.pn * 128 + wc * 32 + 8 * fq;
        if (u.slice >= 0) {
#pragma unroll
            for (int m = 0; m < 4; ++m) { float* rowp = part + ((size_t)u.slice * 128 + wr * 64 + m * 16 + fr) * (2 * FF) + u.pn * BM + wc * 32 + 8 * fq;
#pragma unroll
                for (int bj = 0; bj < 2; ++bj) { *(f32x4*)(rowp + bj * HALF) = acc[0][bj][m][0]; *(f32x4*)(rowp + bj * HALF + 4) = acc[0][bj][m][1]; } }
            return;
        }
#pragma unroll
        for (int ai = 0; ai < 2; ++ai)
#pragma unroll
            for (int m = 0; m < 4; ++m) { bf16_t* rowp = ACT + (size_t)(row0 + ai * HALF + m * 16) * FFP + j0;
                f32x4 a[2];
#pragma unroll
                for (int n = 0; n < 2; ++n) { const f32x4 gv = acc[ai][0][m][n], uv = acc[ai][1][m][n];
#pragma unroll
                    for (int e = 0; e < 4; ++e) a[n][e] = (gv[e] * uv[e]) * __builtin_amdgcn_rcpf(1.f + __builtin_amdgcn_exp2f(gv[e])); }
                u32x4 w; w.x = cvt_pk_bf16(a[0][0], a[0][1]); w.y = cvt_pk_bf16(a[0][2], a[0][3]); w.z = cvt_pk_bf16(a[1][0], a[1][1]); w.w = cvt_pk_bf16(a[1][2], a[1][3]); w = (w + 0x00010000u) & 0xFFFEFFFEu;
                *(u32x4*)rowp = w; }
    }
};

template <class Epi, class Sched, bool ALIGN_EPI = false, bool SP2 = false>
__device__ __forceinline__ void gemm_phase(PG8_LAS unsigned char* lds, const Gemm g, const Sched& S, const Epi& E, int tid_in) {
    int tid = tid_in; asm volatile("" : "+v"(tid));
    const int wid = __builtin_amdgcn_readfirstlane(tid >> 6), lane = tid & 63, wr = wid >> 2, wc = wid & 3, fr = lane & 15, fq = lane >> 4;
    const int nt_full = g.K / BK;
    unsigned voffA[2], voffB[2];
#pragma unroll
    for (int i = 0; i < 2; ++i) { int R, C; stage_rc(tid * 16 + i * 8192, R, C); const int Rb = Epi::PERM ? ((R & ~31) + perm32(R & 31)) : R;
        voffA[i] = (unsigned)(R * g.lda + C) * 2u; voffB[i] = (unsigned)(Rb * g.ldb + C) * 2u; }
    const size_t kstep = (size_t)(BK * 2);
    const size_t hstepA = (size_t)HALF * g.lda * 2, hstepB = (size_t)HALF * g.ldb * 2;
    const size_t tstepA = 2 * hstepA, tstepB = 2 * hstepB;
    const unsigned ldsw = (unsigned)wid * 1024u;
    const int aoff = lds_byte(wr * 64 + fr, fq * 8), boff = lds_byte(wc * 32 + fr, fq * 8);
#define PG8_SA(b, h) (((b) * 2 + (h)) * HTB)
#define PG8_SB(b, h) ((4 + (b) * 2 + (h)) * HTB)
#define PG8_STAGE(bufoff, gbase, voff) do { _Pragma("unroll") for (int _i = 0; _i < 2; ++_i) \
        __builtin_amdgcn_global_load_lds((const unsigned*)((const char*)(gbase) + (voff)[_i]), (PG8_LAS unsigned*)(lds + (bufoff) + ldsw + _i * 8192), 16, 0, 0); } while (0)
#define PG8_LDA(dst, b, h) do { _Pragma("unroll") for (int m = 0; m < 4; ++m) _Pragma("unroll") for (int k = 0; k < 2; ++k) dst[m][k] = *(const PG8_LAS bf16x8*)(lds + PG8_SA(b, h) + aoff + m * 2048 + k * 1024); } while (0)
#define PG8_LDB(dst, b, h) do { _Pragma("unroll") for (int n = 0; n < 2; ++n) _Pragma("unroll") for (int k = 0; k < 2; ++k) dst[n][k] = *(const PG8_LAS bf16x8*)(lds + PG8_SB(b, h) + boff + n * 2048 + k * 1024); } while (0)
#define PG8_MMA(ai, bj, At, Bt) do { __builtin_amdgcn_s_setprio(1); _Pragma("unroll") for (int m = 0; m < 4; ++m) _Pragma("unroll") for (int n = 0; n < 2; ++n) _Pragma("unroll") for (int k = 0; k < 2; ++k) \
        acc[ai][bj][m][n] = __builtin_amdgcn_mfma_f32_16x16x32_bf16(Bt[n][k], At[m][k], acc[ai][bj][m][n], 0, 0, 0); __builtin_amdgcn_s_setprio(0); } while (0)
#define PG8_WAIT_V(n) asm volatile("s_waitcnt vmcnt(" #n ")" ::: "memory")
#define PG8_WAIT_L(n) asm volatile("s_waitcnt lgkmcnt(" #n ")" ::: "memory")
#define PG8_BAR __builtin_amdgcn_s_barrier()
#define PG8_SCHED __builtin_amdgcn_sched_barrier(0)
    Unit cur, nxt; int ui = 0;
    if (!S.next(0, cur)) return;
    f32x4 acc[2][2][4][2];
#pragma unroll
    for (int a = 0; a < 2; ++a)
#pragma unroll
        for (int b = 0; b < 2; ++b)
#pragma unroll
            for (int m = 0; m < 4; ++m)
#pragma unroll
                for (int n = 0; n < 2; ++n) acc[a][b][m][n] = (f32x4){0.f, 0.f, 0.f, 0.f};
    bf16x8 At[4][2], B0[2][2], B1[2][2];
    const char* cA = (const char*)g.A + (size_t)cur.pm * tstepA + g.aofs(cur.pn) + (size_t)cur.kt0 * kstep; const char* cB = (const char*)g.Bt + (size_t)cur.pn * tstepB + (size_t)cur.kt0 * kstep;
    S.a_ready(cur);
    if constexpr (SP2) {
        PG8_STAGE(PG8_SB(0, 0), cB, voffB); PG8_STAGE(PG8_SB(0, 1), cB + hstepB, voffB); PG8_STAGE(PG8_SA(0, 0), cA, voffA); PG8_STAGE(PG8_SA(0, 1), cA + hstepA, voffA);
        if (wr == 1) PG8_BAR;
        PG8_WAIT_V(2); PG8_BAR;
        PG8_STAGE(PG8_SB(1, 0), cB + kstep, voffB); PG8_STAGE(PG8_SA(1, 0), cA + kstep, voffA); PG8_STAGE(PG8_SB(1, 1), cB + hstepB + kstep, voffB);
        PG8_WAIT_V(6); PG8_BAR;
    } else {
        PG8_STAGE(PG8_SB(0, 0), cB, voffB); PG8_STAGE(PG8_SA(0, 0), cA, voffA); PG8_STAGE(PG8_SB(0, 1), cB + hstepB, voffB); PG8_STAGE(PG8_SA(0, 1), cA + hstepA, voffA);
        if (wr == 1) PG8_BAR;
        PG8_WAIT_V(4); PG8_BAR;
        PG8_STAGE(PG8_SB(1, 0), cB + kstep, voffB); PG8_STAGE(PG8_SA(1, 0), cA + kstep, voffA); PG8_STAGE(PG8_SB(1, 1), cB + hstepB + kstep, voffB);
        PG8_WAIT_V(6); PG8_BAR;
    }
    for (;;) {
        const bool has_next = S.next(ui + 1, nxt);
        const char* nA = has_next ? (const char*)g.A + (size_t)nxt.pm * tstepA + g.aofs(nxt.pn) + (size_t)nxt.kt0 * kstep : cA; const char* nB = has_next ? (const char*)g.Bt + (size_t)nxt.pn * tstepB + (size_t)nxt.kt0 * kstep : cB;
        const int nt = cur.nkt > 0 ? cur.nkt : nt_full;
        for (int t = 0; t < nt; t += 2) {
            const bool last = (t == nt - 2);
            const char* a1 = cA + (size_t)(t + 1) * kstep;
            const char* a2 = last ? nA : cA + (size_t)(t + 2) * kstep; const char* b2 = last ? nB : cB + (size_t)(t + 2) * kstep;
            const char* a3 = a2 + kstep; const char* b3 = b2 + kstep;
            if (last && has_next) S.a_ready(nxt);
            if constexpr (SP2) {
            PG8_LDB(B0, 0, 0); PG8_LDB(B1, 0, 1); PG8_SCHED; PG8_LDA(At, 0, 0); PG8_STAGE(PG8_SA(1, 1), a1 + hstepA, voffA);
            PG8_WAIT_V(8); PG8_WAIT_L(0); PG8_BAR; PG8_MMA(0, 0, At, B0); PG8_MMA(0, 1, At, B1); PG8_BAR; PG8_SCHED;
            PG8_LDA(At, 0, 1); PG8_STAGE(PG8_SB(0, 0), b2, voffB); PG8_STAGE(PG8_SB(0, 1), b2 + hstepB, voffB); PG8_STAGE(PG8_SA(0, 0), a2, voffA);
            PG8_WAIT_V(8); PG8_WAIT_L(0); PG8_BAR; PG8_MMA(1, 0, At, B0); PG8_MMA(1, 1, At, B1); PG8_BAR; PG8_SCHED;
            PG8_LDB(B0, 1, 0); PG8_LDB(B1, 1, 1); PG8_SCHED; PG8_LDA(At, 1, 0); PG8_STAGE(PG8_SA(0, 1), a2 + hstepA, voffA);
            PG8_WAIT_V(8); PG8_WAIT_L(0); PG8_BAR; PG8_MMA(0, 0, At, B0); PG8_MMA(0, 1, At, B1); PG8_BAR; PG8_SCHED;
            PG8_LDA(At, 1, 1); PG8_STAGE(PG8_SB(1, 0), b3, voffB); PG8_STAGE(PG8_SB(1, 1), b3 + hstepB, voffB); PG8_STAGE(PG8_SA(1, 0), a3, voffA);
            PG8_WAIT_V(8); PG8_WAIT_L(0); PG8_BAR; PG8_MMA(1, 0, At, B0); PG8_MMA(1, 1, At, B1); PG8_BAR; PG8_SCHED;
            } else {
            PG8_LDB(B0, 0, 0); PG8_SCHED; PG8_LDA(At, 0, 0); PG8_STAGE(PG8_SA(1, 1), a1 + hstepA, voffA);
            PG8_WAIT_L(8); PG8_BAR; PG8_WAIT_L(0); PG8_MMA(0, 0, At, B0); PG8_BAR; PG8_SCHED;
            PG8_LDB(B1, 0, 1); PG8_STAGE(PG8_SB(0, 0), b2, voffB);
            PG8_BAR; PG8_WAIT_L(0); PG8_MMA(0, 1, At, B1); PG8_BAR;
            PG8_LDA(At, 0, 1); PG8_STAGE(PG8_SA(0, 0), a2, voffA);
            PG8_BAR; PG8_WAIT_L(0); PG8_MMA(1, 0, At, B0); PG8_BAR; PG8_SCHED;
            PG8_STAGE(PG8_SB(0, 1), b2 + hstepB, voffB);
            PG8_WAIT_V(6); PG8_BAR; PG8_MMA(1, 1, At, B1); PG8_BAR;
            PG8_LDB(B0, 1, 0); PG8_SCHED; PG8_LDA(At, 1, 0); PG8_STAGE(PG8_SA(0, 1), a2 + hstepA, voffA);
            PG8_WAIT_L(8); PG8_BAR; PG8_WAIT_L(0); PG8_MMA(0, 0, At, B0); PG8_BAR; PG8_SCHED;
            PG8_LDB(B1, 1, 1); PG8_STAGE(PG8_SB(1, 0), b3, voffB);
            PG8_BAR; PG8_WAIT_L(0); PG8_MMA(0, 1, At, B1); PG8_BAR;
            PG8_LDA(At, 1, 1); PG8_STAGE(PG8_SA(1, 0), a3, voffA);
            PG8_BAR; PG8_WAIT_L(0); PG8_MMA(1, 0, At, B0); PG8_BAR; PG8_SCHED;
            PG8_STAGE(PG8_SB(1, 1), b3 + hstepB, voffB);
            PG8_WAIT_V(6); PG8_BAR; PG8_MMA(1, 1, At, B1); PG8_BAR;
            }
        }
        if constexpr (ALIGN_EPI) { if (wr == 0) PG8_BAR; }
        if constexpr (!Epi::AFTER_DRAIN) { E(acc, cur, wr, wc, fr, fq); S.done(cur); }
        if (!has_next) break;
#pragma unroll
        for (int a = 0; a < 2; ++a)
#pragma unroll
            for (int b = 0; b < 2; ++b)
#pragma unroll
                for (int m = 0; m < 4; ++m)
#pragma unroll
                    for (int n = 0; n < 2; ++n) acc[a][b][m][n] = (f32x4){0.f, 0.f, 0.f, 0.f};
        cur = nxt; cA = nA; cB = nB; ++ui;
        if constexpr (ALIGN_EPI) { if (wr == 1) PG8_BAR; }
    }
    PG8_WAIT_V(0);
    if constexpr (!ALIGN_EPI) { if (wr == 0) PG8_BAR; }
    PG8_BAR;
    if constexpr (Epi::AFTER_DRAIN) { E.fused(acc, cur, wr, wc, fr, fq, lds, wid, lane); S.done(cur); }
#undef PG8_SA
#undef PG8_SB
#undef PG8_STAGE
#undef PG8_LDA
#undef PG8_LDB
#undef PG8_MMA
#undef PG8_WAIT_V
#undef PG8_WAIT_L
#undef PG8_BAR
#undef PG8_SCHED
}
}

#define XB_TMO      128
#define XB_XCNT(j)  (256  + 64 * (j))
#define XB_XSUB(j)  (1280 + 64 * (j))
#define XB_XGEN(j)  (2304 + 64 * (j))
#define XB_TOP      3328
#define XB_TOPGEN   3392
#define XCD_BAR_WORDS 3456
#define XB_SPIN_CAP (1u << 18)

__device__ __forceinline__ unsigned xb_ld(unsigned* p)              { return __hip_atomic_load(p, __ATOMIC_RELAXED, __HIP_MEMORY_SCOPE_AGENT); }
__device__ __forceinline__ unsigned xb_add(unsigned* p, unsigned v) { return __hip_atomic_fetch_add(p, v, __ATOMIC_RELAXED, __HIP_MEMORY_SCOPE_AGENT); }
__device__ __forceinline__ unsigned xb_xcc_id() { return (unsigned)__builtin_amdgcn_s_getreg((3 << 11) | 20) & 0xFu; }
#define XB_SPIN(cond, bar) do { unsigned _sp = 0; while (cond) { __builtin_amdgcn_s_sleep(1); \
    if ((++_sp & 255u) == 0u) { if (xb_ld(&(bar)[XB_TMO])) break; if (_sp > XB_SPIN_CAP) { atomicAdd(&(bar)[XB_TMO], 1u); break; } } } } while (0)

struct XcdBarrier {
    unsigned* bar; unsigned x;
    volatile LAS unsigned* st;
};

__device__ __forceinline__ XcdBarrier xcd_barrier_post(unsigned* bar, volatile LAS unsigned* st) {
    XcdBarrier b; b.bar = bar; b.x = xb_xcc_id(); b.st = st;
    if (threadIdx.x == 0) (void)xb_add(&bar[XB_XCNT(b.x)], 1u);
    return b;
}
__device__ __forceinline__ void xcd_barrier_complete(unsigned* bar, unsigned x, unsigned& nloc, unsigned& nx) {
    const unsigned G = gridDim.x * gridDim.y * gridDim.z;
    unsigned sum, cnt, mine, sp = 0u;
    for (;;) {
        sum = 0u; cnt = 0u; mine = 0u;
#pragma unroll
        for (unsigned j = 0; j < 16; ++j) { const unsigned c = xb_ld(&bar[XB_XCNT(j)]); sum += c; cnt += (c > 0u) ? 1u : 0u; mine = (j == x) ? c : mine; }
        if (sum == G) break;
        __builtin_amdgcn_s_sleep(1);
        if ((++sp & 255u) == 0u) { if (xb_ld(&bar[XB_TMO])) break; if (sp > XB_SPIN_CAP) { atomicAdd(&bar[XB_TMO], 1u); break; } }
    }
    nloc = mine > 0u ? mine : 1u; nx = cnt > 0u ? cnt : 1u;
}

__device__ __forceinline__ void xcd_barrier(const XcdBarrier& b, int tid_) {
    asm volatile("s_waitcnt vmcnt(0)" ::: "memory");
    __syncthreads();
    if (tid_ == 0) {
        unsigned* bar = b.bar;
        __builtin_amdgcn_s_waitcnt(0);
        unsigned nloc = b.st[0], nx = b.st[1];
        if (nloc == 0u) { xcd_barrier_complete(bar, b.x, nloc, nx); b.st[0] = nloc; b.st[1] = nx; }
        const unsigned old = xb_add(&bar[XB_XSUB(b.x)], 1u);
        const unsigned gen = old / nloc;
        if (old + 1u == (gen + 1u) * nloc) {
            __builtin_amdgcn_fence(__ATOMIC_RELEASE, "agent");
            asm volatile("s_waitcnt vmcnt(0)" ::: "memory");
            const unsigned og = xb_add(&bar[XB_TOP], 1u);
            const unsigned tg = og / nx;
            if (og + 1u == (tg + 1u) * nx) xb_add(&bar[XB_TOPGEN], 1u);
            else XB_SPIN(xb_ld(&bar[XB_TOPGEN]) == tg, bar);
            __builtin_amdgcn_fence(__ATOMIC_ACQUIRE, "agent");
            xb_add(&bar[XB_XGEN(b.x)], 1u);
            asm volatile("s_waitcnt vmcnt(0)" ::: "memory");
        } else {
            XB_SPIN(xb_ld(&bar[XB_XGEN(b.x)]) == gen, bar);
            __builtin_amdgcn_fence(__ATOMIC_ACQUIRE, "agent");
            asm volatile("s_waitcnt vmcnt(0)" ::: "memory");
        }
    }
    __syncthreads();
}

#define KARG(T, byteoff) (*(T const volatile __attribute__((address_space(4)))*)((const __attribute__((address_space(4))) char*)__builtin_amdgcn_kernarg_segment_ptr() + (byteoff)))
struct WJob { const float* W; bf16_t* WT; int N, Kd, mode, k0, n0; bool ok; };
constexpr int I_IN = (D / 64) * (IND / 64), I_OUT = (VALD / 64) * (D / 64), I_GU = (D / 64) * (2 * FF / 64), I_DN = (FF / 64) * (D / 64), I_PL = 8 * 8;
constexpr int WL_P0 = I_IN;
constexpr int WL_SEQ = I_IN + 2 * I_OUT + 4 * I_GU + 4 * I_DN + 8 * I_PL;
constexpr int SIDE_SLOTS = 65;
static_assert(SIDE_SLOTS * 256 == I_OUT + 2 * I_GU + I_DN + 8 * I_PL, "the first recurrence phase covers exactly the first five groups of the sequence");
__device__ __forceinline__ WJob wjob_decode(int list, int r) {
    WJob j; j.ok = (r >= 0); j.mode = 0; j.N = IND; j.Kd = D; j.k0 = 0; j.n0 = 0;
    int karg = 64; size_t src = 0, dst = WS_WIN;
#define WJ_IN(jj)   do { karg = 64; src = (size_t)(jj) * D * IND; j.N = IND; dst = WS_WIN + (size_t)(jj) * NIN_PAD * D * 2; j.Kd = D; j.mode = 2; } while (0)
#define WJ_OUT(jj)  do { karg = 104; src = (size_t)(jj) * VALD * D; j.N = D; dst = WS_WOUT + (size_t)(jj) * D * VALD * 2; j.Kd = VALD; } while (0)
#define WJ_GU(ii)   do { karg = 128; src = (size_t)(ii) * D * 2 * FF; j.N = 2 * FF; dst = WS_WGU + (size_t)(ii) * 2 * FF * D * 2; j.Kd = D; j.mode = 1; } while (0)
#define WJ_DN(ii)   do { karg = 136; src = (size_t)(ii) * FF * D; j.N = D; dst = WS_WDN + (size_t)(ii) * D * FFP * 2; j.Kd = FFP; } while (0)
#define WJ_PL(ii)   do { karg = 112; src = (size_t)(ii) * 512 * 512; j.N = 512; dst = WS_WPL + (size_t)(ii) * 512 * 512 * 2; j.Kd = 512; } while (0)
    if (list == 0) {
        if (r < I_IN) { WJ_IN(0); } else j.ok = false;
    } else {
        if (r < I_OUT) { WJ_OUT(0); }
        else if ((r -= I_OUT) < I_GU) { WJ_GU(0); }
        else if ((r -= I_GU) < I_DN) { WJ_DN(0); }
        else if ((r -= I_DN) < 8 * I_PL) { const int ii = r / I_PL; r -= ii * I_PL; WJ_PL(ii); }
        else if ((r -= 8 * I_PL) < I_GU) { WJ_GU(1); }
        else if ((r -= I_GU) < I_OUT) { WJ_OUT(1); }
        else if ((r -= I_OUT) < I_GU) { WJ_GU(2); }
        else if ((r -= I_GU) < I_DN) { WJ_DN(2); }
        else if ((r -= I_DN) < I_GU) { WJ_GU(3); }
        else if ((r -= I_GU) < I_DN) { WJ_DN(3); }
        else if ((r -= I_DN) < I_DN) { WJ_DN(1); }
        else if ((r -= I_DN) < I_IN) { WJ_IN(1); }
        else j.ok = false;
    }
#undef WJ_IN
#undef WJ_OUT
#undef WJ_GU
#undef WJ_DN
#undef WJ_PL
    j.W = KARG(const float*, karg) + src; j.WT = (bf16_t*)(KARG(unsigned char*, 152) + dst);
    if (j.ok) { const int nblk = j.N / 64, kb = r / nblk, nb = r % nblk; j.k0 = 64 * kb; j.n0 = 64 * nb; }
    return j;
}
__device__ __forceinline__ float wjob_scale(int n0, int mode) { return mode == 1 ? (n0 < FF ? -1.4426950408889634f : -0.6931471805599453f) : (mode == 2 && n0 >= QKVD && n0 < QKVD + VALD) ? -1.4426950408889634f : 1.f; }
__device__ __forceinline__ int wjob_row(int n, int mode) {
    if (mode == 1) { const int jj = n < FF ? n : n - FF; return (jj >> 7) * 256 + (jj & 127) + (n < FF ? 0 : 128); }
    return n;
}

__device__ __forceinline__ void transpose_item(const float* __restrict__ W, int N, bf16_t* __restrict__ WT, int Kd, int k0, int n0, int mode, LAS float* scr, int lane) {
    float t[64];
    const float wsc = wjob_scale(n0, mode);
#pragma unroll
    for (int i = 0; i < 64; ++i) t[i] = W[(size_t)(k0 + i) * N + n0 + lane];
#pragma unroll
    for (int i = 0; i < 64; ++i) scr[i * 65 + lane] = t[i] * wsc;
    asm volatile("s_waitcnt lgkmcnt(0)" ::: "memory");
    const int c = lane & 7;
#pragma unroll
    for (int j = 0; j < 8; ++j) { const int n = (lane >> 3) + 8 * j; const LAS float* s = scr + (8 * c) * 65 + n;
        u32x4 o; o.x = pk2(s[0 * 65], s[1 * 65]); o.y = pk2(s[2 * 65], s[3 * 65]); o.z = pk2(s[4 * 65], s[5 * 65]); o.w = pk2(s[6 * 65], s[7 * 65]); o = (o + 0x00010000u) & 0xFFFEFFFEu;
        int nn = n0 + n; if (mode == 1) { const int jj = nn < FF ? nn : nn - FF; nn = (jj >> 7) * 256 + (jj & 127) + (nn < FF ? 0 : 128); }
        *(u32x4*)(WT + (size_t)nn * Kd + k0 + 8 * c) = o; }
    asm volatile("s_waitcnt lgkmcnt(0)" ::: "memory");
}
__device__ __forceinline__ void transpose_matrix(const float* W, int K, int N, bf16_t* WT, int mode, LAS float* scr, int gw, int ngw, int lane) {
    const int nblk = N / 64, items = (K / 64) * nblk;
    for (int it = gw; it < items; it += ngw) { const int kb = it / nblk, nb = it % nblk; transpose_item(W, N, WT, K, 64 * kb, 64 * nb, mode, scr, lane); }
}

template <int MODE>
__device__ __forceinline__ void norm_row(f16_t* __restrict__ X, const float* __restrict__ w, bf16_t* __restrict__ H, float* __restrict__ out_a, float* __restrict__ out_b, int lane,
                                         const float* __restrict__ part, int nsl, int m, f16x8 h0, f16x8 h1, f16x8 h2, f16x8 h3) {
        if (m >= MT) { if (MODE != 2) {
#pragma unroll
                for (int j = 0; j < 8; ++j) *(u32x2*)(H + (size_t)m * D + 4 * (lane + 64 * j)) = (u32x2){0u, 0u}; }
            return; }
#define VI(j) (2 * (lane + 64 * ((j) >> 1)) + ((j) & 1))
        f32x4 v[8]; float ss = 0.f;
        if (MODE == 3) {
            const f32x4* xr = (const f32x4*)(m < MP ? out_a + (size_t)m * D : out_b + (size_t)(m - MP) * D);
#pragma unroll
            for (int j = 0; j < 8; ++j) v[j] = xr[VI(j)];
            if (m >= MP) {
#pragma unroll
                for (int jj = 0; jj < 4; ++jj) { const f16x4 a = __builtin_convertvector(v[2 * jj], f16x4), b = __builtin_convertvector(v[2 * jj + 1], f16x4);
                    ((f16x8*)(X + (size_t)m * D))[lane + 64 * jj] = (f16x8){a[0], a[1], a[2], a[3], b[0], b[1], b[2], b[3]}; }
            }
        } else {
            const f16x8 h[4] = {h0, h1, h2, h3};
#pragma unroll
            for (int jj = 0; jj < 4; ++jj) { v[2 * jj] = (f32x4){(float)h[jj][0], (float)h[jj][1], (float)h[jj][2], (float)h[jj][3]}; v[2 * jj + 1] = (f32x4){(float)h[jj][4], (float)h[jj][5], (float)h[jj][6], (float)h[jj][7]}; }
        }
        if (nsl > 0 && m >= MP) {
            const size_t sstep = (size_t)128 * D / 4;
            int s = 0;
            for (; s + 4 <= nsl; s += 4) {
                const f32x4* pr = (const f32x4*)(part + ((size_t)s * 128 + (m - MP)) * D);
                f32x4 t0[8], t1[8], t2[8], t3[8];
#pragma unroll
                for (int j = 0; j < 8; ++j) { t0[j] = pr[VI(j)]; t1[j] = pr[sstep + VI(j)]; t2[j] = pr[2 * sstep + VI(j)]; t3[j] = pr[3 * sstep + VI(j)]; }
#pragma unroll
                for (int j = 0; j < 8; ++j) v[j] = v[j] + ((t0[j] + t1[j]) + (t2[j] + t3[j])); }
            for (; s < nsl; s += 2) {
                const f32x4* pr = (const f32x4*)(part + ((size_t)s * 128 + (m - MP)) * D);
                f32x4 t0[8], t1[8];
#pragma unroll
                for (int j = 0; j < 8; ++j) { t0[j] = pr[VI(j)]; t1[j] = pr[sstep + VI(j)]; }
#pragma unroll
                for (int j = 0; j < 8; ++j) v[j] = v[j] + (t0[j] + t1[j]); }
#pragma unroll
            for (int jj = 0; jj < 4; ++jj) { const f16x4 a = __builtin_convertvector(v[2 * jj], f16x4), b = __builtin_convertvector(v[2 * jj + 1], f16x4);
                const f16x8 hx = (f16x8){a[0], a[1], a[2], a[3], b[0], b[1], b[2], b[3]};
                ((f16x8*)(X + (size_t)m * D))[lane + 64 * jj] = hx;
                v[2 * jj] = __builtin_convertvector(a, f32x4); v[2 * jj + 1] = __builtin_convertvector(b, f32x4); }
        }
#pragma unroll
        for (int j = 0; j < 8; ++j) ss += (v[j][0] * v[j][0] + v[j][1] * v[j][1]) + (v[j][2] * v[j][2] + v[j][3] * v[j][3]);
        ss = wave_sum(ss);
        const float r = rsqrtf(ss * (1.f / D) + EPS);
        float* tail = nullptr;
        if (MODE == 1) { if (m < MP) { const int t = m & 2047; if (t >= 2033) tail = out_a + ((size_t)(m >> 11) * 15 + (t - 2033)) * D; }
                         else { const int t = (m - MP) & 15; if (t >= 1) tail = out_b + ((size_t)((m - MP) >> 4) * 15 + (t - 1)) * D; } }
        if (MODE == 2) tail = out_a + (size_t)m * D;
#pragma unroll
        for (int jj = 0; jj < 4; ++jj) { const f32x4 w0 = ((const f32x4*)w)[VI(2 * jj)], w1 = ((const f32x4*)w)[VI(2 * jj + 1)]; const f32x4 y0 = v[2 * jj] * r * w0, y1 = v[2 * jj + 1] * r * w1;
            if (MODE != 2) { u32x4 o; o.x = pk2(y0[0], y0[1]); o.y = pk2(y0[2], y0[3]); o.z = pk2(y1[0], y1[1]); o.w = pk2(y1[2], y1[3]); o = (o + 0x00010000u) & 0xFFFEFFFEu; *(u32x4*)(H + (size_t)m * D + 8 * (lane + 64 * jj)) = o; }
            if ((MODE == 1 || MODE == 2) && tail) { *(f32x4*)(tail + 4 * VI(2 * jj)) = y0; *(f32x4*)(tail + 4 * VI(2 * jj + 1)) = y1; } }
#undef VI
}
template <int MODE>
__device__ __forceinline__ void norm_phase(f16_t* __restrict__ X, const float* __restrict__ w, bf16_t* __restrict__ H, float* __restrict__ out_a, float* __restrict__ out_b, int gw, int ngw, int lane,
                                           const float* __restrict__ part, int nsl) {
    const bool rebal = (ngw == 2048);
    const int kmax = rebal ? 10 : (MPAD + ngw - 1) / ngw;
    auto row_of = [&](int k) -> int {
        if (!rebal) { const int m = gw + k * ngw; return m < MPAD ? m : -1; }
        if (k == 0) return gw < 256 ? MP + gw : -1;
        if (k <= 8) return gw >= 128 ? gw + 2048 * (k - 1) : -1;
        if (gw < 128 || gw >= 1152) return -1;
        const int e = gw - 128; return (e & 127) + 2048 * (e >> 7);
    };
    int k = 0, m = -1;
    for (; k < kmax; ++k) { m = row_of(k); if (m >= 0) break; }
    f16x8 h[4] = {};
    if (MODE != 3 && m >= 0 && m < MT) {
#pragma unroll
        for (int jj = 0; jj < 4; ++jj) h[jj] = ((const f16x8*)(X + (size_t)m * D))[lane + 64 * jj];
    }
    while (m >= 0) {
        int kn = k + 1, mn = -1;
        for (; kn < kmax; ++kn) { mn = row_of(kn); if (mn >= 0) break; }
        f16x8 hn[4] = {h[0], h[1], h[2], h[3]};
        if (MODE != 3 && mn >= 0 && mn < MT) {
#pragma unroll
            for (int jj = 0; jj < 4; ++jj) hn[jj] = ((const f16x8*)(X + (size_t)mn * D))[lane + 64 * jj];
        }
        const int m_ = m; const f16x8 h0 = h[0], h1 = h[1], h2 = h[2], h3 = h[3];
        h[0] = hn[0]; h[1] = hn[1]; h[2] = hn[2]; h[3] = hn[3]; m = mn; k = kn;
        norm_row<MODE>(X, w, H, out_a, out_b, lane, part, nsl, m_, h0, h1, h2, h3);
    }
}


__device__ __forceinline__ void swiglu_reduce_phase(const float* __restrict__ part, int nsl, bf16_t* __restrict__ ACT, int gw, int ngw, int lane) {
    constexpr int NB = FF / 512;
    for (int it = gw; it < 256 * NB; it += ngw) {
        const int r = it / NB, blk = it % NB, j0 = blk * 512 + lane * 8;
        u32x4 w = (u32x4){0u, 0u, 0u, 0u};
        if (r < MS) {
            f32x4 a[4]; a[0] = a[1] = a[2] = a[3] = (f32x4){0.f, 0.f, 0.f, 0.f};
            for (int s = 0; s < nsl; s += 4) {
                f32x4 t[4][4];
#pragma unroll
                for (int k = 0; k < 4; ++k) { const f32x4* p = (const f32x4*)(part + ((size_t)(s + k) * 128 + r) * (2 * FF) + (j0 >> 7) * 256 + (j0 & 127));
                    t[k][0] = p[0]; t[k][1] = p[32]; t[k][2] = p[1]; t[k][3] = p[33]; }
#pragma unroll
                for (int i = 0; i < 4; ++i) a[i] = a[i] + ((t[0][i] + t[1][i]) + (t[2][i] + t[3][i])); }
            float o[8];
#pragma unroll
            for (int e = 0; e < 4; ++e) { o[e] = a[0][e] * a[1][e] * __builtin_amdgcn_rcpf(1.f + __builtin_amdgcn_exp2f(a[0][e])); o[4 + e] = a[2][e] * a[3][e] * __builtin_amdgcn_rcpf(1.f + __builtin_amdgcn_exp2f(a[2][e])); }
            w.x = pk2(o[0], o[1]); w.y = pk2(o[2], o[3]); w.z = pk2(o[4], o[5]); w.w = pk2(o[6], o[7]);
        }
        *(u32x4*)(ACT + (size_t)(MP + r) * FFP + j0) = w;
    }
}

__device__ __forceinline__ f32x4 bf4_to_f32(u32x2 q) { return (f32x4){__uint_as_float(q.x << 16), __uint_as_float(q.x & 0xffff0000u), __uint_as_float(q.y << 16), __uint_as_float(q.y & 0xffff0000u)}; }
template <int W>
__device__ __forceinline__ void pool_run(const bf16_t* __restrict__ H, bf16_t* __restrict__ DP, int row0, int tpos0, int c) {
    f32x4 prev[16], cur[16];
#pragma unroll
    for (int i = 0; i < 16; ++i) prev[i] = (f32x4){0.f, 0.f, 0.f, 0.f};
    if (tpos0 > 0) {
#pragma unroll
        for (int i = 16 - (W - 1); i < 16; ++i) prev[i] = bf4_to_f32(*(const u32x2*)(H + (size_t)(row0 - 16 + i) * D + c));
    }
    u32x2 nraw[16];
#pragma unroll
    for (int i = 0; i < 16; ++i) nraw[i] = *(const u32x2*)(H + (size_t)(row0 + i) * D + c);
#pragma unroll 1
    for (int g = 0; g < 4; ++g) {
#pragma unroll
        for (int i = 0; i < 16; ++i) cur[i] = bf4_to_f32(nraw[i]);
        if (g + 1 < 4) {
#pragma unroll
            for (int i = 0; i < 16; ++i) nraw[i] = *(const u32x2*)(H + (size_t)(row0 + 16 * (g + 1) + i) * D + c);
        }
        f32x4 S = (f32x4){0.f, 0.f, 0.f, 0.f};
#pragma unroll
        for (int i = 1; i < W; ++i) S = S + prev[16 - i];
#pragma unroll
        for (int tl = 0; tl < 16; ++tl) {
            S = S + cur[tl];
            const int t = tpos0 + 16 * g + tl; const int cnt = (t + 1) < W ? (t + 1) : W;
            const f32x4 dd = S * (1.f / (float)cnt) - cur[tl];
            u32x2 o; o.x = pk2(dd[0], dd[1]); o.y = pk2(dd[2], dd[3]);
            *(u32x2*)(DP + (size_t)(row0 + 16 * g + tl) * D + c) = o;
            S = S - ((tl - W + 1 >= 0) ? cur[(tl - W + 1 >= 0) ? (tl - W + 1) : 0] : prev[(tl - W + 1 >= 0) ? 0 : (16 + tl - W + 1)]);
        }
#pragma unroll
        for (int i = 16 - (W - 1); i < 16; ++i) prev[i] = cur[i];
    }
}
template <int W>
__device__ __forceinline__ void pool_row_sample(const bf16_t* __restrict__ H, const float* __restrict__ hist, bf16_t* __restrict__ DP, int m, int c) {
    const int b = (m - MP) >> 4, t = (m - MP) & 15, base = MP + b * 16, end = t + 16;
    f32x4 S = (f32x4){0.f, 0.f, 0.f, 0.f}, me = S;
#pragma unroll
    for (int i = 0; i < W; ++i) { const int p = end - W + i;
        const f32x4 xv = (p < 15) ? *(const f32x4*)(hist + ((size_t)b * 15 + p) * D + c) : bf4_to_f32(*(const u32x2*)(H + (size_t)(base + p - 15) * D + c));
        S = S + xv; me = xv; }
    const f32x4 dd = S * (1.f / (float)W) - me;
    u32x2 o; o.x = pk2(dd[0], dd[1]); o.y = pk2(dd[2], dd[3]);
    *(u32x2*)(DP + (size_t)m * D + c) = o;
}
__device__ __forceinline__ void pool_phase(const bf16_t* __restrict__ H, const float* __restrict__ hist, bf16_t* __restrict__ DP, int bid, int G, int tid) {
    const int c = tid * 4, gi = __builtin_amdgcn_readfirstlane(tid >> 7);
    for (int run = bid; run < MP / 64; run += G) {
        const int row0 = run * 64, tpos0 = (run & 31) * 64;
        if (gi == 0) pool_run<2>(H, DP, row0, tpos0, c); else if (gi == 1) pool_run<4>(H, DP, row0, tpos0, c); else if (gi == 2) pool_run<8>(H, DP, row0, tpos0, c); else pool_run<16>(H, DP, row0, tpos0, c);
    }
    for (int m = MP + bid; m < MPAD; m += G) {
        if (m >= MT) { *(u32x2*)(DP + (size_t)m * D + c) = (u32x2){0u, 0u}; continue; }
        if (gi == 0) pool_row_sample<2>(H, hist, DP, m, c); else if (gi == 1) pool_row_sample<4>(H, hist, DP, m, c); else if (gi == 2) pool_row_sample<8>(H, hist, DP, m, c); else pool_row_sample<16>(H, hist, DP, m, c);
    }
}

#ifndef PROBE
#define PROBE 0
#endif
#define RREP(k) _Pragma("unroll") for (int rrep_ = 0; rrep_ < ((PROBE) == (k) ? 2 : 1); ++rrep_)
constexpr int R_SET = 37888;
constexpr int R_KR = 0, R_VT = 8704, R_QR = 18944, R_KT = 27648;
constexpr int R_OB = 0;
constexpr int R_WR = 2 * R_SET;
constexpr int R_VN = R_WR + 8704, R_VN2 = R_VN + 10240;
constexpr int R_ST = R_VN2 + 10240;
constexpr int R_TM1 = R_ST + 34816, R_TM2 = R_TM1 + 2560, R_AM = R_TM2 + 2560;
constexpr int R_LD = R_AM + 2560;
constexpr int R_L10 = R_LD + 2048, R_TT0 = R_L10 + 768, R_T11 = R_TT0 + 768, R_M1 = R_T11 + 768;
constexpr int R_G = R_M1 + 768;
constexpr int R_CW = R_G + 2048;
constexpr int R_END = R_CW + 6144;
static_assert(R_END <= LDS_BYTES - 512 && R_OB + 16896 <= R_QR, "R phase LDS map");

__device__ __forceinline__ f32x4 mfma16(bf16x8 a, bf16x8 b, f32x4 c) { return __builtin_amdgcn_mfma_f32_16x16x32_bf16(a, b, c, 0, 0, 0); }
__device__ __forceinline__ u32x2 pack4(f32x4 v) { u32x2 r; r.x = pk2(v[0], v[1]); r.y = pk2(v[2], v[3]); return r; }
#define R_LDSFENCE() asm volatile("s_waitcnt lgkmcnt(0)" ::: "memory")

__device__ __forceinline__ void rec_stream(LAS unsigned char* lds, const bf16_t* __restrict__ PROJ, const float* __restrict__ LOGIT, size_t row0, int T, int hv,
                                           const float* __restrict__ hist, const float* __restrict__ cw, const float* __restrict__ S0, float Aneg, float dtb,
                                           const float* __restrict__ nw, bf16_t* __restrict__ OG, float* __restrict__ Sout, int tid,
                                           int side_item0, int side_stride) {
    asm volatile("" : "+v"(tid));
    const int wave = __builtin_amdgcn_readfirstlane(tid >> 6), lane = tid & 63, hk = hv >> 1;
    int fr = lane & 15, fq = lane >> 4;
#define R_OPAQUE() do { int l_ = lane; asm volatile("" : "+v"(l_)); fr = l_ & 15; fq = l_ >> 4; } while (0)
    const bf16x8 zero8 = (bf16x8){0, 0, 0, 0, 0, 0, 0, 0};
    const __amdgpu_buffer_rsrc_t rs_s0 = __builtin_amdgcn_make_buffer_rsrc((void*)S0, 0, S0 ? 65536 : 0, 0x00020000);
    const __amdgpu_buffer_rsrc_t rs_so = __builtin_amdgcn_make_buffer_rsrc((void*)Sout, 0, 65536, 0x00020000);
    const int vo_s = ((4 * fq) * 128 + 16 * wave + fr) * 4;
    f32x4 Sacc[8];
#pragma unroll
    for (int i = 0; i < 8; ++i)
#pragma unroll
        for (int r = 0; r < 4; ++r) Sacc[i][r] = __uint_as_float(__builtin_amdgcn_raw_buffer_load_b32(rs_s0, vo_s, (16 * i + r) * 512, 0));
#pragma unroll
    for (int i = 0; i < 8; ++i) *(LAS u32x2*)(lds + R_ST + (16 * wave + fr) * 272 + (16 * i + 4 * fq) * 2) = pack4(Sacc[i]);
    __builtin_amdgcn_s_waitcnt(0x0F70);
    if (tid < 48) { const int which = tid >> 4, c = tid & 15; LAS unsigned char* p = lds + (which == 0 ? R_AM : which == 1 ? R_TM1 : R_TM2) + c * 80 + 32;
        *(LAS u32x4*)p = (u32x4){0u, 0u, 0u, 0u}; *(LAS u32x4*)(p + 16) = (u32x4){0u, 0u, 0u, 0u}; }
    const bool prep = wave >= 1 && wave <= 6;
    const int seg = (wave - 1) >> 1, th = (tid - 64) & 127, chunk8 = th & 15, tg = th >> 4;
    const int chan = (seg == 0 ? hk * 128 : seg == 1 ? 2048 + hk * 128 : 4096 + hv * 128) + chunk8 * 8;
    if (prep && tg == 0) {
#pragma unroll
        for (int j = 0; j < 4; ++j) { *(LAS f32x4*)(lds + R_CW + ((seg * 16 + chunk8) * 4 + j) * 32) = *(const f32x4*)(cw + (size_t)j * QKVD + chan) * -1.4426950408889634f;
                                      *(LAS f32x4*)(lds + R_CW + ((seg * 16 + chunk8) * 4 + j) * 32 + 16) = *(const f32x4*)(cw + (size_t)j * QKVD + chan + 4) * -1.4426950408889634f; }
    }
    const f32x4 nwa = *(const f32x4*)(nw + 8 * (lane & 15)) * -0.6931471805599453f, nwb = *(const f32x4*)(nw + 8 * (lane & 15) + 4) * -0.6931471805599453f;
    const __amdgpu_buffer_rsrc_t rs_proj = __builtin_amdgcn_make_buffer_rsrc((void*)(PROJ - 3 * PROJW), 0, (int)((size_t)(MPAD + 3) * PROJW * 2), 0x00020000);
    const __amdgpu_buffer_rsrc_t rs_og = __builtin_amdgcn_make_buffer_rsrc((void*)OG, 0, (int)((size_t)MPAD * VALD * 2), 0x00020000);
    const int vo_pre = ((tg * 4) * PROJW + chan) * 2;
    const int vo_z = ((3 + (lane >> 4)) * PROJW + 8192 + hv * 128 + 8 * (lane & 15)) * 2, vo_og = ((lane >> 4) * VALD + hv * 128 + 8 * (lane & 15)) * 2;
    u32x4 pre[7]; float lg_b = 0.f, lg_a = 0.f; u32x4 zpre = (u32x4){0u, 0u, 0u, 0u};
    const int nch = (T + 31) >> 5;
#define REC_PREFETCH(ch) do { const int t0_ = (ch) * 32; const int so_ = (int)((row0 + t0_) * (size_t)(PROJW * 2)); \
        if (prep) { _Pragma("unroll") for (int i = 0; i < 7; ++i) pre[i] = __builtin_amdgcn_raw_buffer_load_b128(rs_proj, vo_pre, so_ + i * (PROJW * 2), 0); } \
        if (wave == 7 && lane < 32) { lg_b = LOGIT[(row0 + t0_ + lane) * 64 + hv]; lg_a = LOGIT[(row0 + t0_ + lane) * 64 + 32 + hv]; } } while (0)
    REC_PREFETCH(0);
    WJob jbB; jbB.ok = false; float wt[64];
#define SIDE_LOAD(jb) do { const __amdgpu_buffer_rsrc_t rs_w = __builtin_amdgcn_make_buffer_rsrc((void*)(jb).W, 0, 0x7ffffff0, 0x00020000); \
        const int vo_w = ((jb).n0 + lane) * 4, ld_w = (jb).N * 4, so_w = (jb).k0 * ld_w; \
        _Pragma("unroll") for (int i = 0; i < 64; ++i) wt[i] = __uint_as_float(__builtin_amdgcn_raw_buffer_load_b32(rs_w, vo_w, so_w + i * ld_w, 0)); } while (0)
#define SIDE_STORE(jb) do { bf16_t* dst = (jb).WT + (size_t)wjob_row((jb).n0 + lane, (jb).mode) * (jb).Kd + (jb).k0; const float sc_ = wjob_scale((jb).n0, (jb).mode); \
        _Pragma("unroll") for (int c = 0; c < 8; ++c) { u32x4 o; o.x = pk2(wt[8 * c] * sc_, wt[8 * c + 1] * sc_); o.y = pk2(wt[8 * c + 2] * sc_, wt[8 * c + 3] * sc_); o.z = pk2(wt[8 * c + 4] * sc_, wt[8 * c + 5] * sc_); o.w = pk2(wt[8 * c + 6] * sc_, wt[8 * c + 7] * sc_); o = (o + 0x00010000u) & 0xFFFEFFFEu; \
            *(u32x4*)(dst + 8 * c) = o; } } while (0)
#define SIDE_KILL() do { _Pragma("unroll") for (int i = 0; i < 64; ++i) asm volatile("" : "=v"(wt[i])); } while (0)
    for (int n = -1; n < nch; ++n) {
        const int t0 = n * 32;
        LAS unsigned char* setc = lds + (n & 1) * R_SET;
        LAS float* GC = (LAS float*)(lds + R_G + (n & 1) * 1024); LAS float* BETA = GC + 32; LAS float* EGC = GC + 64; LAS float* BE1 = GC + 96; LAS float* EGL = GC + 128; LAS float* GLp = GC + 160;
        R_OPAQUE();
        if (wave == 7) { if (jbB.ok) SIDE_STORE(jbB); jbB.ok = false; }
        if (n >= 0) {
            if (wave < 6) {
                const int arow0 = (wave == 1 || wave == 5) ? 16 : 0, brow0 = (wave == 0 || wave == 3) ? 0 : 16;
                const LAS unsigned char* Ab = setc + R_KR + (arow0 + fr) * 272 + fq * 16;
                const LAS unsigned char* Bb = setc + (wave < 3 ? R_KR : R_QR) + (brow0 + fr) * 272 + fq * 16;
                f32x4 d = (f32x4){0.f, 0.f, 0.f, 0.f};
#pragma unroll
                for (int ks = 0; ks < 4; ++ks) d = mfma16(*(const LAS bf16x8*)(Ab + ks * 64), *(const LAS bf16x8*)(Bb + ks * 64), d);
                const int c = brow0 + fr, s0 = arow0 + 4 * fq;
                const float gcc = GC[c]; const f32x4 gcs = *(const LAS f32x4*)(GC + s0);
                const float bc = (wave < 3) ? BETA[c] : 1.f;
                f32x4 v;
#pragma unroll
                for (int r = 0; r < 4; ++r) { const int s = s0 + r; const bool ok = (wave < 3) ? (c > s) : (s <= c); v[r] = ok ? d[r] * bc * __expf(gcc - gcs[r]) : 0.f; }
                if (wave < 2) *(LAS f32x4*)(lds + R_LD + (wave * 256 + fr * 16 + 4 * fq) * 4) = v;
                else if (wave == 2) *(LAS u32x2*)(lds + R_L10 + fr * 48 + (4 * fq) * 2) = pack4(v);
                else *(LAS u32x2*)(lds + R_AM + c * 80 + s0 * 2) = pack4(v);
            }
        }
        __syncthreads();
        R_OPAQUE();
        if (wave == 0) {
            SIDE_KILL();
            if (n >= 0) {
            if (fq < 2) {
                const int blk = fq, c = fr;
                const LAS float* L = (const LAS float*)(lds + R_LD) + blk * 256;
                float Tr[16];
#pragma unroll
                for (int j = 0; j < 16; ++j) Tr[j] = (j == c) ? 1.f : 0.f;
#pragma unroll
                for (int j = 15; j >= 1; --j) {
                    const float tj = Tr[j];
#pragma unroll
                    for (int s4 = 0; s4 * 4 < j; ++s4) { const f32x4 l4 = *(const LAS f32x4*)(L + j * 16 + 4 * s4);
#pragma unroll
                        for (int e = 0; e < 4; ++e) if (4 * s4 + e < j) Tr[4 * s4 + e] -= tj * l4[e]; }
                    if ((j & 3) == 0) asm volatile("" ::: "memory");
                }
                LAS unsigned char* t1 = lds + R_TM1 + (16 * blk + c) * 80 + (16 * blk) * 2; LAS unsigned char* t2 = lds + R_TM2 + (16 * blk + c) * 80 + (16 * blk) * 2;
#pragma unroll
                for (int s4 = 0; s4 < 4; ++s4) { const f32x4 b1 = *(const LAS f32x4*)(BE1 + 16 * blk + 4 * s4), b2 = *(const LAS f32x4*)(BETA + 16 * blk + 4 * s4);
                    const f32x4 tv = (f32x4){Tr[4 * s4], Tr[4 * s4 + 1], Tr[4 * s4 + 2], Tr[4 * s4 + 3]};
                    *(LAS u32x2*)(t1 + s4 * 8) = pack4(tv * b1); *(LAS u32x2*)(t2 + s4 * 8) = pack4(tv * b2); }
                if (blk == 0) {
#pragma unroll
                    for (int j = 0; j < 16; ++j) *(LAS bf16_t*)(lds + R_TT0 + j * 48 + c * 2) = (bf16_t)f2bf(Tr[j]);
                } else {
#pragma unroll
                    for (int s4 = 0; s4 < 4; ++s4) *(LAS u32x2*)(lds + R_T11 + c * 48 + s4 * 8) = pack4((f32x4){Tr[4 * s4], Tr[4 * s4 + 1], Tr[4 * s4 + 2], Tr[4 * s4 + 3]});
                }
            }
            R_LDSFENCE();
            bf16x8 a = zero8, b = zero8;
            if (fq < 2) { a = *(const LAS bf16x8*)(lds + R_L10 + fr * 48 + fq * 16); b = *(const LAS bf16x8*)(lds + R_TT0 + fr * 48 + fq * 16); }
            f32x4 m1 = mfma16(a, b, (f32x4){0.f, 0.f, 0.f, 0.f});
            *(LAS u32x2*)(lds + R_M1 + fr * 48 + (4 * fq) * 2) = pack4(m1);
            R_LDSFENCE();
            a = zero8; b = zero8;
            if (fq < 2) { a = *(const LAS bf16x8*)(lds + R_T11 + fr * 48 + fq * 16); b = *(const LAS bf16x8*)(lds + R_M1 + fr * 48 + fq * 16); }
            const f32x4 t10 = mfma16(a, b, (f32x4){0.f, 0.f, 0.f, 0.f});
            const float be1 = BE1[fr], be2 = BETA[fr];
#pragma unroll
            for (int r = 0; r < 4; ++r) { *(LAS bf16_t*)(lds + R_TM1 + (16 + 4 * fq + r) * 80 + fr * 2) = (bf16_t)f2bf(-t10[r] * be1);
                                           *(LAS bf16_t*)(lds + R_TM2 + (16 + 4 * fq + r) * 80 + fr * 2) = (bf16_t)f2bf(-t10[r] * be2); }
            }
        } else if (n + 1 < nch) {
            const int t1 = (n + 1) * 32;
            LAS unsigned char* setn = lds + ((n + 1) & 1) * R_SET;
            if (prep) {
                SIDE_KILL();
                const int chunk8 = fr, tg = 4 * ((wave - 1) & 1) + fq;
                float cwr[4][8];
#pragma unroll
                for (int j = 0; j < 4; ++j) { const f32x4 c0 = *(const LAS f32x4*)(lds + R_CW + ((seg * 16 + chunk8) * 4 + j) * 32), c1 = *(const LAS f32x4*)(lds + R_CW + ((seg * 16 + chunk8) * 4 + j) * 32 + 16);
                    cwr[j][0] = c0[0]; cwr[j][1] = c0[1]; cwr[j][2] = c0[2]; cwr[j][3] = c0[3]; cwr[j][4] = c1[0]; cwr[j][5] = c1[1]; cwr[j][6] = c1[2]; cwr[j][7] = c1[3]; }
                float xw[3][8];
#pragma unroll
                for (int i = 0; i < 3; ++i) { const unsigned wv[4] = {pre[i].x, pre[i].y, pre[i].z, pre[i].w};
#pragma unroll
                    for (int e = 0; e < 4; ++e) { xw[i][2 * e] = __uint_as_float(wv[e] << 16); xw[i][2 * e + 1] = __uint_as_float(wv[e] & 0xffff0000u); } }
                if (n + 1 == 0 && tg == 0) {
                    const __amdgpu_buffer_rsrc_t rs_hist = __builtin_amdgcn_make_buffer_rsrc((void*)hist, 0, hist ? 3 * QKVD * 4 : 0, 0x00020000);
                    const int vo_hist = ((seg == 0 ? hk * 128 : seg == 1 ? 2048 + hk * 128 : 4096 + hv * 128) + chunk8 * 8) * 4;
#pragma unroll
                    for (int i = 0; i < 3; ++i)
#pragma unroll
                        for (int e = 0; e < 8; ++e) xw[i][e] = __uint_as_float(__builtin_amdgcn_raw_buffer_load_b32(rs_hist, vo_hist + e * 4, i * (QKVD * 4), 0));
                }
                float y[4][8];
#pragma unroll
                for (int i = 0; i < 4; ++i) {
                    float xn[8]; { const unsigned wv[4] = {pre[i + 3].x, pre[i + 3].y, pre[i + 3].z, pre[i + 3].w};
#pragma unroll
                        for (int e = 0; e < 4; ++e) { xn[2 * e] = __uint_as_float(wv[e] << 16); xn[2 * e + 1] = __uint_as_float(wv[e] & 0xffff0000u); } }
                    float a[8], tt[8];
#pragma unroll
                    for (int e = 0; e < 8; ++e) a[e] = cwr[0][e] * xw[0][e];
#pragma unroll
                    for (int e = 0; e < 8; ++e) a[e] += cwr[1][e] * xw[1][e];
#pragma unroll
                    for (int e = 0; e < 8; ++e) a[e] += cwr[2][e] * xw[2][e];
#pragma unroll
                    for (int e = 0; e < 8; ++e) a[e] += cwr[3][e] * xn[e];
#pragma unroll
                    for (int e = 0; e < 8; ++e) tt[e] = __builtin_amdgcn_exp2f(a[e]);
#pragma unroll
                    for (int e = 0; e < 8; ++e) tt[e] = 1.f + tt[e];
#pragma unroll
                    for (int e = 0; e < 8; ++e) tt[e] = __builtin_amdgcn_rcpf(tt[e]);
#pragma unroll
                    for (int e = 0; e < 8; ++e) { a[e] *= tt[e]; y[i][e] = a[e]; }
                    float ss0 = a[0] * a[0], ss1 = a[1] * a[1], ss2 = a[2] * a[2], ss3 = a[3] * a[3];
                    ss0 += a[4] * a[4]; ss1 += a[5] * a[5]; ss2 += a[6] * a[6]; ss3 += a[7] * a[7];
                    ss0 += ss2; ss1 += ss3;
#pragma unroll
                    for (int e = 0; e < 8; ++e) { xw[0][e] = xw[1][e]; xw[1][e] = xw[2][e]; xw[2][e] = xn[e]; }
                    float r = -0.6931471805599453f;
                    if (seg < 2) { const float ss = row16_sum(ss0 + ss1);
                        r *= __builtin_amdgcn_rsqf(ss * 0.4804530139182014f + EPS); if (seg == 0) r *= 0.08838834764831845f; }
#pragma unroll
                    for (int e = 0; e < 8; ++e) y[i][e] *= r;
                }
                if (seg < 2) {
                    LAS unsigned char* dst = setn + (seg == 0 ? R_QR : R_KR) + (tg * 4) * 272 + chunk8 * 16;
#pragma unroll
                    for (int i = 0; i < 4; ++i) { u32x4 w; w.x = pk2(y[i][0], y[i][1]); w.y = pk2(y[i][2], y[i][3]); w.z = pk2(y[i][4], y[i][5]); w.w = pk2(y[i][6], y[i][7]); *(LAS u32x4*)(dst + i * 272) = w; }
                }
                if (seg >= 1) {
                    LAS unsigned char* dst = setn + (seg == 1 ? R_KT : R_VT) + (chunk8 * 8) * 80 + (tg * 4) * 2;
#pragma unroll
                    for (int e = 0; e < 8; ++e) { u32x2 w; w.x = pk2(y[0][e], y[1][e]); w.y = pk2(y[2][e], y[3][e]); *(LAS u32x2*)(dst + e * 80) = w; }
                }
            }
            if (wave == 7) {
                LAS float* GCn = (LAS float*)(lds + R_G + ((n + 1) & 1) * 1024);
                const bool valid = lane < 32 && (t1 + lane) < T;
                const float xs = lg_a + dtb, en = __expf(-fabsf(xs));
                const float l1p = en < 0.01f ? en * (1.f - en * (0.5f - en * (1.f / 3.f))) : __logf(1.f + en);
                const float sp = fmaxf(xs, 0.f) + l1p;
                float gc = valid ? Aneg * sp : 0.f; const float beta = valid ? __builtin_amdgcn_rcpf(1.f + __expf(-lg_b)) : 0.f;
#pragma unroll
                for (int d = 1; d < 32; d <<= 1) { const float o = __shfl_up(gc, d); if (lane >= d) gc += o; }
                const float gl = __shfl(gc, 31);
                const float e = __expf(gc);
                if (lane < 32) { GCn[lane] = gc; GCn[32 + lane] = beta; GCn[64 + lane] = e; GCn[96 + lane] = beta * e; GCn[128 + lane] = __expf(gl - gc); if (lane == 31) GCn[160] = e; }
                jbB = wjob_decode(1, side_item0 + (n + 1) * side_stride); if (jbB.ok) SIDE_LOAD(jbB);
            }
        }
        if (n >= 0) zpre = __builtin_amdgcn_raw_buffer_load_b128(rs_proj, vo_z, (int)((row0 + t0 + wave * 4) * (size_t)(PROJW * 2)), 0);
        if (n + 2 < nch) REC_PREFETCH(n + 2);
        __syncthreads();
        if (n < 0) continue;
        R_OPAQUE();
        f32x4 u[2];
        {
            const bf16x8 aK = *(const LAS bf16x8*)(setc + R_KT + (16 * wave + fr) * 80 + fq * 16);
            const bf16x8 bV = *(const LAS bf16x8*)(setc + R_VT + (16 * wave + fr) * 80 + fq * 16);
#pragma unroll
            for (int t = 0; t < 2; ++t) {
                const f32x4 wt = mfma16(aK, *(const LAS bf16x8*)(lds + R_TM1 + (16 * t + fr) * 80 + fq * 16), (f32x4){0.f, 0.f, 0.f, 0.f});
                *(LAS u32x2*)(lds + R_WR + (16 * t + fr) * 272 + (16 * wave + 4 * fq) * 2) = pack4(wt);
                u[t] = mfma16(*(const LAS bf16x8*)(lds + R_TM2 + (16 * t + fr) * 80 + fq * 16), bV, (f32x4){0.f, 0.f, 0.f, 0.f});
            }
        }
        __syncthreads();
        R_OPAQUE();
        f32x4 acc1[2], acc2[2];
        acc1[0] = acc1[1] = acc2[0] = acc2[1] = (f32x4){0.f, 0.f, 0.f, 0.f};
#pragma unroll
        for (int ks = 0; ks < 4; ++ks) {
            const bf16x8 bS = *(const LAS bf16x8*)(lds + R_ST + (16 * wave + fr) * 272 + ks * 64 + fq * 16);
#pragma unroll
            for (int t = 0; t < 2; ++t) {
                acc1[t] = mfma16(*(const LAS bf16x8*)(lds + R_WR + (16 * t + fr) * 272 + ks * 64 + fq * 16), bS, acc1[t]);
                acc2[t] = mfma16(*(const LAS bf16x8*)(setc + R_QR + (16 * t + fr) * 272 + ks * 64 + fq * 16), bS, acc2[t]);
            }
        }
#pragma unroll
        for (int t = 0; t < 2; ++t) {
            const f32x4 egl4 = *(const LAS f32x4*)(EGL + 16 * t + 4 * fq), egc4 = *(const LAS f32x4*)(EGC + 16 * t + 4 * fq);
            const f32x4 vn = u[t] - acc1[t];
            *(LAS u32x2*)(lds + R_VN + (16 * wave + fr) * 80 + (16 * t + 4 * fq) * 2) = pack4(vn);
            *(LAS u32x2*)(lds + R_VN2 + (16 * wave + fr) * 80 + (16 * t + 4 * fq) * 2) = pack4(vn * egl4);
            acc2[t] = acc2[t] * egc4;
        }
        R_LDSFENCE();
        {
            const bf16x8 bVN = *(const LAS bf16x8*)(lds + R_VN + (16 * wave + fr) * 80 + fq * 16);
            const bf16x8 bVN2 = *(const LAS bf16x8*)(lds + R_VN2 + (16 * wave + fr) * 80 + fq * 16);
#pragma unroll
            for (int t = 0; t < 2; ++t) acc2[t] = mfma16(*(const LAS bf16x8*)(lds + R_AM + (16 * t + fr) * 80 + fq * 16), bVN, acc2[t]);
            const float gl = __uint_as_float(__builtin_amdgcn_readfirstlane(__float_as_uint(GLp[0])));
#pragma unroll
            for (int i = 0; i < 8; ++i) Sacc[i] = mfma16(*(const LAS bf16x8*)(setc + R_KT + (16 * i + fr) * 80 + fq * 16), bVN2, Sacc[i] * gl);
        }
#pragma unroll
        for (int i = 0; i < 8; ++i) *(LAS u32x2*)(lds + R_ST + (16 * wave + fr) * 272 + (16 * i + 4 * fq) * 2) = pack4(Sacc[i]);
#pragma unroll
        for (int t = 0; t < 2; ++t)
#pragma unroll
            for (int r = 0; r < 4; ++r) *(LAS float*)(setc + R_OB + ((16 * t + 4 * fq + r) * 132 + 16 * wave + fr) * 4) = acc2[t][r];
        __syncthreads();
        {
            const int tok = fq, sg = fr, tt = wave * 4 + tok;
            const f32x4 o0 = *(const LAS f32x4*)(setc + R_OB + (tt * 132 + 8 * sg) * 4), o1 = *(const LAS f32x4*)(setc + R_OB + (tt * 132 + 8 * sg + 4) * 4);
            float ss = (o0[0] * o0[0] + o0[1] * o0[1]) + (o0[2] * o0[2] + o0[3] * o0[3]) + (o1[0] * o1[0] + o1[1] * o1[1]) + (o1[2] * o1[2] + o1[3] * o1[3]);
            ss = row16_sum(ss);
            const float r = __builtin_amdgcn_rsqf(ss * (1.f / 128.f) + EPS);
            const unsigned zw[4] = {zpre.x, zpre.y, zpre.z, zpre.w};
            float g[8];
#pragma unroll
            for (int e = 0; e < 4; ++e) { const float z0 = __uint_as_float(zw[e] << 16), z1 = __uint_as_float(zw[e] & 0xffff0000u); g[2 * e] = z0 * __builtin_amdgcn_rcpf(1.f + __builtin_amdgcn_exp2f(z0)); g[2 * e + 1] = z1 * __builtin_amdgcn_rcpf(1.f + __builtin_amdgcn_exp2f(z1)); }
            u32x4 w;
            w.x = pk2(o0[0] * r * nwa[0] * g[0], o0[1] * r * nwa[1] * g[1]); w.y = pk2(o0[2] * r * nwa[2] * g[2], o0[3] * r * nwa[3] * g[3]);
            w.z = pk2(o1[0] * r * nwb[0] * g[4], o1[1] * r * nwb[1] * g[5]); w.w = pk2(o1[2] * r * nwb[2] * g[6], o1[3] * r * nwb[3] * g[7]);
            if (t0 + tt < T) __builtin_amdgcn_raw_buffer_store_b128(w, rs_og, vo_og, (int)((row0 + t0 + wave * 4) * (size_t)(VALD * 2)), 0);
        }
    }
    R_OPAQUE();
    const int vo_so = ((4 * fq) * 128 + 16 * wave + fr) * 4;
#undef REC_PREFETCH
#undef R_OPAQUE
#undef SIDE_LOAD
#undef SIDE_STORE
#undef SIDE_KILL
#pragma unroll
    for (int i = 0; i < 8; ++i)
#pragma unroll
        for (int r = 0; r < 4; ++r) __builtin_amdgcn_raw_buffer_store_b32(__float_as_uint(Sacc[i][r]), rs_so, vo_so, (16 * i + r) * 512, 0);
    __syncthreads();
}

struct Args { const float* in[18]; float* out; unsigned char* ws; int lo, hi; };
constexpr int NSTEPS = 64;
constexpr int SLICE_KT_GU = 8;
constexpr int SLICE_KT = 4, NSL_OUT = VALD / 64 / SLICE_KT, NSL_DN = FF / 64 / SLICE_KT, NSL_PL = 512 / 64 / SLICE_KT;
#ifndef PROBE
#define PROBE 0
#endif
#define REP(k) _Pragma("unroll") for (int rep_ = 0; rep_ < ((PROBE) == (k) ? 2 : 1); ++rep_)

__global__ void __launch_bounds__(512, 2) mega(Args a) {
    extern __shared__ __attribute__((aligned(16))) unsigned char lds_raw[];
    LAS unsigned char* lds = (LAS unsigned char*)lds_raw;
    volatile LAS unsigned* MISC = (volatile LAS unsigned*)(lds + MISC_OFF);
    const int G = gridDim.x, bx = blockIdx.x, vcu = (G % 8 == 0) ? (bx % 8) * (G / 8) + bx / 8 : bx;
    const int ngw = G * 8;
    const int lo = a.lo, hi = a.hi;
    unsigned* ctl = (unsigned*)(a.ws + WS_CTL);
    const int wave_k = __builtin_amdgcn_readfirstlane((int)threadIdx.x >> 6);
    if (threadIdx.x < 64) MISC[threadIdx.x] = 0u;
    __syncthreads();
    XcdBarrier bar; bar.bar = ctl + CW_BAR; bar.x = 0; bar.st = MISC + 8;
    if (hi - lo > 1) bar = xcd_barrier_post(ctl + CW_BAR, MISC + 8);

#define LOAD_PTRS \
    const float* x_prompt = KARG(const float*, 0); const float* x_sample = KARG(const float*, 8); const float* st_conv = KARG(const float*, 16); const float* st_S = KARG(const float*, 24); \
    const float* st_pool = KARG(const float*, 32); const float* norm_mix_w = KARG(const float*, 40); const float* norm_ffn_w = KARG(const float*, 48); const float* final_norm_w = KARG(const float*, 56); \
    const float* w_in = KARG(const float*, 64); const float* conv_w = KARG(const float*, 72); const float* A_log = KARG(const float*, 80); const float* dt_bias = KARG(const float*, 88); \
    const float* gnorm_w = KARG(const float*, 96); const float* w_out = KARG(const float*, 104); const float* pool_w = KARG(const float*, 112); const float* pool_scale = KARG(const float*, 120); \
    const float* w_gu = KARG(const float*, 128); const float* w_down = KARG(const float*, 136); float* out = KARG(float*, 144); unsigned char* ws = KARG(unsigned char*, 152); \
    bf16_t* WIN = (bf16_t*)(ws + WS_WIN); bf16_t* WOUT = (bf16_t*)(ws + WS_WOUT); bf16_t* WGU = (bf16_t*)(ws + WS_WGU); bf16_t* WDN = (bf16_t*)(ws + WS_WDN); bf16_t* WPL = (bf16_t*)(ws + WS_WPL); \
    f16_t* X = (f16_t*)(ws + WS_X); bf16_t* H = (bf16_t*)(ws + WS_H); bf16_t* PROJ = (bf16_t*)(ws + WS_PROJ); bf16_t* ACT = PROJ; float* LOGIT = (float*)(ws + WS_LOGIT); \
    bf16_t* OG = (bf16_t*)(ws + WS_OG); bf16_t* DP = OG; float* PART = (float*)(ws + WS_PART); \
    (void)x_prompt; (void)x_sample; (void)st_conv; (void)st_S; (void)st_pool; (void)norm_mix_w; (void)norm_ffn_w; (void)final_norm_w; (void)w_in; (void)conv_w; (void)A_log; (void)dt_bias; (void)gnorm_w; \
    (void)w_out; (void)pool_w; (void)pool_scale; (void)w_gu; (void)w_down; (void)out; (void)WIN; (void)WOUT; (void)WGU; (void)WDN; (void)WPL; (void)X; (void)H; (void)PROJ; (void)ACT; (void)LOGIT; (void)OG; (void)DP; (void)PART;

    int step = 0;
#define STEP_BEGIN if (step >= lo && step < hi) { int tid; asm volatile("v_mbcnt_lo_u32_b32 %0, -1, 0\n\tv_mbcnt_hi_u32_b32 %0, -1, %0" : "=v"(tid)); tid += wave_k * 64; asm volatile("" : "+v"(tid)); const int lane = tid & 63, wave = __builtin_amdgcn_readfirstlane(tid >> 6), gw = vcu * 8 + wave; int bxo = bx; asm volatile("" : "+s"(bxo)); int ngwo = ngw; asm volatile("" : "+s"(ngwo)); (void)lane; (void)gw; (void)bxo; (void)ngwo; LOAD_PTRS
#define STEP_END   if (step + 1 < hi) xcd_barrier(bar, tid); } ++step;

    STEP_BEGIN
    REP(5) {
        LAS float* scr = (LAS float*)(lds + wave * 16640);
        for (int it = gw; it < WL_P0; it += ngw) { const WJob jb = wjob_decode(0, it); transpose_item(jb.W, jb.N, jb.WT, jb.Kd, jb.k0, jb.n0, jb.mode, scr, lane); }
        for (int it = (G == 256 ? 2 * SIDE_SLOTS * 256 : 0) + gw; it < WL_SEQ; it += ngw) { const WJob jb = wjob_decode(1, it); transpose_item(jb.W, jb.N, jb.WT, jb.Kd, jb.k0, jb.n0, jb.mode, scr, lane); }
        const size_t gt = (size_t)vcu * 512 + tid, ngt = (size_t)G * 512;
        for (size_t i = gt; i < (size_t)2 * (NIN_PAD - IND) * D / 8; i += ngt) { const size_t j = i / ((size_t)(NIN_PAD - IND) * D / 8), r = i % ((size_t)(NIN_PAD - IND) * D / 8);
            ((u32x4*)(WIN + (size_t)j * NIN_PAD * D + (size_t)IND * D))[r] = (u32x4){0u, 0u, 0u, 0u}; }
        for (size_t i = gt; i < (size_t)(MPAD - MT) * VALD / 8; i += ngt) ((u32x4*)(OG + (size_t)MT * VALD))[i] = (u32x4){0u, 0u, 0u, 0u};
        if (rep_ == 0) norm_phase<3>(X, norm_mix_w, H, const_cast<float*>(x_prompt), const_cast<float*>(x_sample), gw, ngwo, lane, PART, 0);
    }
    STEP_END

    for (int layer = 0; layer < 4; ++layer) {
        const int j = layer >> 1;
        if (layer > 0) {
        STEP_BEGIN
        REP(4) { const int nsl_ = (layer > 0 && rep_ == 0) ? NSL_DN : 0;
          if (layer & 1) norm_phase<1>(X, norm_mix_w + (size_t)layer * D, H, out + O_POOL_P + (size_t)j * 8 * 15 * D, out + O_POOL_S + (size_t)j * 8 * 15 * D, gw, ngwo, lane, PART, nsl_);
        else norm_phase<0>(X, norm_mix_w + (size_t)layer * D, H, nullptr, nullptr, gw, ngwo, lane, PART, nsl_); }
        STEP_END
        }
        if ((layer & 1) == 0) {
            STEP_BEGIN
            REP(2) { pg8::Gemm g{H, WIN + (size_t)j * NIN_PAD * D, D, D, NPANEL, NIN_PAD / 256, D, 0, 0}; pg8::StaticOrder S; S.init(NPANEL, NIN_PAD / 256, G, bxo);
              pg8::EpiInProj E{PROJ, LOGIT, out + O_CONV_P + (size_t)j * 8 * 3 * QKVD, out + O_CONV_S + (size_t)j * 8 * 3 * QKVD};
              pg8::gemm_phase<pg8::EpiInProj, pg8::StaticOrder, true, true>(lds, g, S, E, tid);
              if (PROBE == 20) { pg8::EpiNull E0{}; __syncthreads(); pg8::gemm_phase<pg8::EpiNull, pg8::StaticOrder, true, true>(lds, g, S, E0, tid); } }
            STEP_END
            STEP_BEGIN
            REP(1) {
                const float* cw = conv_w + (size_t)j * 4 * QKVD;
                for (int it = bxo; it < 512; it += G) {
                    const int sample = it >= 256, bh = it & 255, b = bh >> 5, hv = bh & 31;
                    const float Aneg = -expf(A_log[j * NVH + hv]), dtb = dt_bias[j * NVH + hv];
                    const size_t so = ((size_t)(j * 8 + b) * NVH + hv) * 128 * 128;
                    rec_stream(lds, PROJ, LOGIT, sample ? (size_t)MP + b * 16 : (size_t)b * 2048, sample ? 16 : 2048, hv,
                               sample ? st_conv + ((size_t)(j * 8 + b) * 3) * QKVD : nullptr, cw, sample ? st_S + so : nullptr, Aneg, dtb, gnorm_w + (size_t)j * 128, OG,
                               out + (sample ? O_S_S : O_S_P) + so, tid, G == 256 ? (j * SIDE_SLOTS + (sample ? 64 : 0)) * G + bxo : -(1 << 30), G);
                }
            }
            STEP_END
            STEP_BEGIN
            { pg8::Gemm g{OG, WOUT + (size_t)j * D * VALD, VALD, VALD, NPANEL, D / 256, VALD, 0, 0}; pg8::SplitOrder S; S.init2(NPANEL - 1, D / 256, G, bxo, VALD / 64, SLICE_KT);
              pg8::EpiResidual E{X, layer == 0 ? x_prompt : nullptr, nullptr, PART};
              pg8::gemm_phase<pg8::EpiResidual, pg8::SplitOrder, true, true>(lds, g, S, E, tid);
              if (PROBE == 7) { pg8::EpiResidual E2{(f16_t*)(ws + WS_PROJ + (size_t)200 * 1024 * 1024), nullptr, nullptr, PART}; __syncthreads(); pg8::gemm_phase<pg8::EpiResidual, pg8::SplitOrder, true, true>(lds, g, S, E2, tid); } }
            STEP_END
        } else {
            STEP_BEGIN
            REP(8) pool_phase(H, st_pool + (size_t)j * 8 * 15 * D, DP, vcu, G, tid);
            STEP_END
            STEP_BEGIN
            { pg8::Gemm g{DP, WPL + (size_t)j * D * 512, D, 512, NPANEL, D / 256, 512, 1, 512}; pg8::SplitOrder S; S.init2(NPANEL - 1, D / 256, G, bxo, 512 / 64, SLICE_KT);
              pg8::EpiResidual E{X, nullptr, pool_scale + (size_t)j * D, PART};
              pg8::gemm_phase<pg8::EpiResidual, pg8::SplitOrder, true, true>(lds, g, S, E, tid);
              if (PROBE == 9) { pg8::EpiResidual E2{(f16_t*)(ws + WS_PROJ + (size_t)200 * 1024 * 1024), nullptr, pool_scale + (size_t)j * D, PART}; __syncthreads(); pg8::gemm_phase<pg8::EpiResidual, pg8::SplitOrder, true, true>(lds, g, S, E2, tid); } }
            STEP_END
        }
        STEP_BEGIN
        REP(4) norm_phase<0>(X, norm_ffn_w + (size_t)layer * D, H, nullptr, nullptr, gw, ngwo, lane, PART, rep_ != 0 ? 0 : ((layer & 1) == 0 ? NSL_OUT : NSL_PL));
        STEP_END
        STEP_BEGIN
        REP(3) { pg8::Gemm g{H, WGU + (size_t)layer * 2 * FF * D, D, D, NPANEL, 2 * FF / 256, D, 0, 0}; pg8::SplitOrder S; S.init2(NPANEL - 1, 2 * FF / 256, G, bxo, D / 64, SLICE_KT_GU, pg8::WGM_WIDE);
          pg8::EpiSwiGLU E{ACT, PART};
          pg8::gemm_phase<pg8::EpiSwiGLU, pg8::SplitOrder, true, true>(lds, g, S, E, tid); }
        STEP_END
        STEP_BEGIN
        swiglu_reduce_phase(PART, D / 64 / SLICE_KT_GU, ACT, gw, ngw, lane);
        STEP_END
        STEP_BEGIN
        { pg8::Gemm g{ACT, WDN + (size_t)layer * D * FFP, FFP, FFP, NPANEL, D / 256, FF, 0, 0}; pg8::SplitOrder S; S.init2(NPANEL - 1, D / 256, G, bxo, FF / 64, SLICE_KT);
          pg8::EpiResidual E{X, nullptr, nullptr, PART};
          pg8::gemm_phase<pg8::EpiResidual, pg8::SplitOrder, true, true>(lds, g, S, E, tid);
          if (PROBE == 6) { pg8::EpiResidual E2{(f16_t*)(ws + WS_PROJ + (size_t)200 * 1024 * 1024), nullptr, nullptr, PART}; __syncthreads(); pg8::gemm_phase<pg8::EpiResidual, pg8::SplitOrder, true, true>(lds, g, S, E2, tid); } }
        STEP_END
    }
    STEP_BEGIN
    REP(4) norm_phase<2>(X, final_norm_w, nullptr, out, nullptr, gw, ngwo, lane, PART, rep_ == 0 ? NSL_DN : 0);
    STEP_END
#undef STEP_BEGIN
#undef STEP_END
}

#ifndef MK_ONE_LAUNCH
#define MK_ONE_LAUNCH 1
#endif
extern "C" void kernel_launch(void* const* d_in, const int* in_sizes, int n_in, void* d_out, int out_size, void* d_ws, size_t ws_size, hipStream_t stream) {
    static int grid = 0;
    if (grid == 0) {
        if (n_in != 18 || ws_size < WS_END) { fprintf(stderr, "kernel_launch: expected 18 inputs and >= %zu bytes of workspace (got %d, %zu)\n", (size_t)WS_END, n_in, ws_size); grid = -1; return; }
        int dev = 0, cus = 0, per_cu = 0;
        if (hipGetDevice(&dev) != hipSuccess || hipDeviceGetAttribute(&cus, hipDeviceAttributeMultiprocessorCount, dev) != hipSuccess) { grid = -1; return; }
        if (hipFuncSetAttribute((const void*)mega, hipFuncAttributeMaxDynamicSharedMemorySize, LDS_BYTES) != hipSuccess) { fprintf(stderr, "kernel_launch: hipFuncSetAttribute failed\n"); grid = -1; return; }
        if (hipOccupancyMaxActiveBlocksPerMultiprocessor(&per_cu, (const void*)mega, 512, LDS_BYTES) != hipSuccess || per_cu < 1) fprintf(stderr, "kernel_launch: occupancy query reports %d\n", per_cu);
        (void)hipGetLastError();
        grid = cus;
    }
    if (grid < 0) return;
    hipMemsetAsync((char*)d_ws + WS_CTL, 0, CTL_BYTES, stream);
    Args a{};
    for (int i = 0; i < 18; ++i) a.in[i] = (const float*)d_in[i];
    a.out = (float*)d_out; a.ws = (unsigned char*)d_ws;
#if MK_ONE_LAUNCH
    a.lo = 0; a.hi = NSTEPS;
    hipLaunchKernelGGL(mega, dim3(grid), dim3(512), LDS_BYTES, stream, a);
#else
    for (int s = 0; s < NSTEPS; ++s) { a.lo = s; a.hi = s + 1; hipLaunchKernelGGL(mega, dim3(grid), dim3(512), LDS_BYTES, stream, a); }
#endif
}
```
